# Optimizing an MI355X kernel written in HIP

```python
import math
import jax, jax.numpy as jnp
from jax import lax
import numpy as np

D_MODEL = 2048
BATCH = 8
SEQ = 2048
DEPTH = 2

N_META = 16
GRID_W = 64
BLOCK = 128
HEAD_DIM = 128
D_FF = 4 * D_MODEL
NORM_EPS = 1e-6
ROPE_THETA = 10000.0
MIX_WIDTH = D_MODEL
ATT_WIDTH = 3 * MIX_WIDTH // 4
ATT_HEADS = ATT_WIDTH // HEAD_DIM
ATT_KV_HEADS = ATT_HEADS // 3
ATT_KV_WIDTH = ATT_KV_HEADS * HEAD_DIM
S5_WIDTH = MIX_WIDTH - ATT_WIDTH
S5_GROUP = 16
S5_GROUPS = S5_WIDTH // S5_GROUP
S5_STATE = 64
EVEN_IN = ATT_WIDTH + 2 * ATT_KV_WIDTH + S5_WIDTH
RET_WIDTH = MIX_WIDTH // 2
RET_HEADS = RET_WIDTH // HEAD_DIM
ML_WIDTH = MIX_WIDTH - RET_WIDTH
ML_HEADS = ML_WIDTH // HEAD_DIM
CONV_W = 5
NEG_GATE = -1e4
ODD_IN = 4 * RET_WIDTH + 2 * ML_WIDTH + 4 * ML_HEADS
N_EVEN = (DEPTH + 1) // 2
N_ODD = DEPTH // 2

kernel_name = 'hybrid_bidir_attn_s5_retnet_mlstm'


def rms_norm(x, g):
    xf = x.astype(jnp.float32)
    y = xf * lax.rsqrt(jnp.mean(xf * xf, axis=-1, keepdims=True) + NORM_EPS)
    return (y * g.astype(jnp.float32)).astype(x.dtype)


def head_layer_norm(x, g):
    b, l, h, d = x.shape
    xf = x.astype(jnp.float32)
    xc = xf - jnp.mean(xf, axis=-1, keepdims=True)
    y = xc * lax.rsqrt(jnp.mean(xc * xc, axis=-1, keepdims=True) + NORM_EPS)
    return y.reshape(b, l, h * d) * g.astype(jnp.float32)


def rope_freqs(dim):
    return ROPE_THETA ** (-jnp.arange(dim // 2, dtype=jnp.float32) / (dim // 2))


def rope(x, ang):
    c = jnp.cos(ang)[None, :, None, :]
    s = jnp.sin(ang)[None, :, None, :]
    x1, x2 = jnp.split(x.astype(jnp.float32), 2, axis=-1)
    return jnp.concatenate([x1 * c - x2 * s, x1 * s + x2 * c], axis=-1).astype(x.dtype)


def axial_rope(x, ang_row, ang_col):
    half = x.shape[-1] // 2
    return jnp.concatenate([rope(x[..., :half], ang_row), rope(x[..., half:], ang_col)], axis=-1)


def grid_positions(n_tok):
    rows = n_tok // GRID_W
    row = jnp.concatenate([-jnp.ones((N_META,), jnp.float32),
                           jnp.repeat(jnp.arange(rows, dtype=jnp.float32), GRID_W)])
    col = jnp.concatenate([jnp.arange(N_META, dtype=jnp.float32),
                           jnp.tile(jnp.arange(GRID_W, dtype=jnp.float32), rows)])
    return row, col


def pad_front(a, n):
    return jnp.pad(a, [(0, 0), (n, 0)] + [(0, 0)] * (a.ndim - 2))


def flip_t(a):
    return jnp.flip(a, axis=1)


def sq_relu_mlp(x, w1, w2):
    return jnp.square(jax.nn.relu(x @ w1)) @ w2


def grid_attention(q, k, v):
    b, l, h, d = q.shape
    kvh = k.shape[2]
    grp = h // kvh
    pad = (-l) % BLOCK
    nb = (l + pad) // BLOCK
    qb = pad_front(q, pad).reshape(b, nb, BLOCK, kvh, grp, d).transpose(1, 0, 2, 3, 4, 5)
    scale = d ** -0.5

    def attend(q_blk):
        s = jnp.einsum('bqkgd,bskd->bkgqs', q_blk, k).astype(jnp.float32) * scale
        p = jax.nn.softmax(s, axis=-1).astype(v.dtype)
        return jnp.einsum('bkgqs,bskd->bqkgd', p, v)

    out = lax.map(attend, qb)
    return out.transpose(1, 0, 2, 3, 4, 5).reshape(b, nb * BLOCK, h * d)[:, pad:]


def _complex_scan_combine(left, right):
    a1r, a1i, b1r, b1i = left
    a2r, a2i, b2r, b2i = right
    return (a1r * a2r - a1i * a2i,
            a1r * a2i + a1i * a2r,
            a2r * b1r - a2i * b1i + b2r,
            a2r * b1i + a2i * b1r + b2i)


def s5_direction(u, lam_re, lam_im, log_dt, b_re, b_im, c_re, c_im):
    lr = jnp.minimum(lam_re, -1e-4)
    li = lam_im
    dt = jnp.exp(log_dt)[:, None]
    er = jnp.exp(lr * dt)
    abar_re = er * jnp.cos(li * dt)
    abar_im = er * jnp.sin(li * dt)
    nr = abar_re - 1.0
    den = lr * lr + li * li
    coef_re = (nr * lr + abar_im * li) / den
    coef_im = (abar_im * lr - nr * li) / den
    bbar_re = coef_re[..., None] * b_re - coef_im[..., None] * b_im
    bbar_im = coef_re[..., None] * b_im + coef_im[..., None] * b_re
    bu_re = jnp.einsum('blgh,gph->blgp', u, bbar_re)
    bu_im = jnp.einsum('blgh,gph->blgp', u, bbar_im)
    n_pos = u.shape[1]
    a_re = jnp.broadcast_to(abar_re, (1, n_pos) + abar_re.shape)
    a_im = jnp.broadcast_to(abar_im, (1, n_pos) + abar_im.shape)
    _, _, x_re, x_im = lax.associative_scan(_complex_scan_combine, (a_re, a_im, bu_re, bu_im), axis=1)
    return jnp.einsum('blgp,ghp->blgh', x_re, c_re) - jnp.einsum('blgp,ghp->blgh', x_im, c_im)


def s5_mixer(u, lam_re, lam_im, log_dt, b_re, b_im, c_re, c_im, d_skip, glu_w, glu_b):
    b, l, _ = u.shape
    f32 = jnp.float32
    uf = u.astype(f32).reshape(b, l, S5_GROUPS, S5_GROUP)
    lam_re, lam_im, log_dt = lam_re.astype(f32), lam_im.astype(f32), log_dt.astype(f32)
    b_re, b_im, c_re, c_im = b_re.astype(f32), b_im.astype(f32), c_re.astype(f32), c_im.astype(f32)
    y_fw = s5_direction(uf, lam_re[0], lam_im[0], log_dt[0], b_re[0], b_im[0], c_re[0], c_im[0])
    y_bw = flip_t(s5_direction(flip_t(uf), lam_re[1], lam_im[1], log_dt[1], b_re[1], b_im[1], c_re[1], c_im[1]))
    y = y_fw + y_bw + d_skip.astype(f32) * uf
    y = jax.nn.gelu(y.reshape(b, l, S5_WIDTH))
    return y * jax.nn.sigmoid(y @ glu_w.astype(f32) + glu_b.astype(f32))


def retention_direction(q, k, v, log_gamma, strict):
    b, lp, h, dk = q.shape
    dv = v.shape[-1]
    nc = lp // BLOCK
    qc = q.reshape(b, nc, BLOCK, h, dk)
    kc = k.reshape(b, nc, BLOCK, h, dk)
    vc = v.reshape(b, nc, BLOCK, h, dv)
    idx = jnp.arange(BLOCK, dtype=jnp.float32)
    diff = idx[:, None] - idx[None, :]
    mask = (diff > 0) if strict else (diff >= 0)
    decay = jnp.where(mask, jnp.exp(jnp.where(mask, diff, 0.0)[None] * log_gamma[:, None, None]), 0.0)
    scores = jnp.einsum('bnqhd,bnshd->bnhqs', qc, kc) * decay
    intra = jnp.einsum('bnhqs,bnshe->bnqhe', scores, vc)
    zeta = jnp.exp((BLOCK - 1 - idx)[:, None] * log_gamma[None, :])
    kv = jnp.einsum('bnshd,bnshe->bnhde', kc * zeta[:, :, None], vc)
    g_chunk = jnp.exp(BLOCK * log_gamma)[None, :, None, None]

    def step(r, kv_c):
        return g_chunk * r + kv_c, r

    _, r_prev = lax.scan(step, jnp.zeros((b, h, dk, dv), kv.dtype), kv.transpose(1, 0, 2, 3, 4))
    xi = jnp.exp((idx + 1.0)[:, None] * log_gamma[None, :])
    inter = jnp.einsum('bnqhd,nbhde->bnqhe', qc, r_prev) * xi[None, None, :, :, None]
    return (intra + inter).reshape(b, lp, h, dv)


def mlstm_direction(q, k, v, log_i, log_f):
    b, lp, h, d = q.shape
    nc = lp // BLOCK
    f32 = jnp.float32
    qc = q.reshape(b, nc, BLOCK, h, d)
    kc = k.reshape(b, nc, BLOCK, h, d)
    vc = v.reshape(b, nc, BLOCK, h, d)
    li = log_i.reshape(b, nc, BLOCK, h).transpose(0, 1, 3, 2)
    bt = jnp.cumsum(log_f.reshape(b, nc, BLOCK, h).transpose(0, 1, 3, 2), axis=-1)
    lower = jnp.tril(jnp.ones((BLOCK, BLOCK), bool))
    dlog = jnp.where(lower, bt[..., :, None] - bt[..., None, :] + li[..., None, :], -jnp.inf)
    a = bt[..., -1:] - bt + li
    m_loc = jnp.max(a, axis=-1)
    w = jnp.exp(a - m_loc[..., None])
    c_loc = jnp.einsum('bnhs,bnshd,bnshe->bnhde', w, kc, vc)
    n_loc = jnp.einsum('bnhs,bnshd->bnhd', w, kc)

    def step(carry, inp):
        c_s, n_s, m_s = carry
        b_last, m_c, c_c, n_c = inp
        m_new = jnp.maximum(b_last + m_s, m_c)
        f_prev = jnp.exp(b_last + m_s - m_new)
        f_loc = jnp.exp(m_c - m_new)
        c_new = f_prev[..., None, None] * c_s + f_loc[..., None, None] * c_c
        n_new = f_prev[..., None] * n_s + f_loc[..., None] * n_c
        return (c_new, n_new, m_new), (c_s, n_s, m_s)

    init = (jnp.zeros((b, h, d, d), c_loc.dtype), jnp.zeros((b, h, d), n_loc.dtype), jnp.zeros((b, h), f32))
    xs = (bt[..., -1].transpose(1, 0, 2), m_loc.transpose(1, 0, 2),
          c_loc.transpose(1, 0, 2, 3, 4), n_loc.transpose(1, 0, 2, 3))
    _, (c_prev, n_prev, m_prev) = lax.scan(step, init, xs)
    c_prev = c_prev.transpose(1, 0, 2, 3, 4)
    n_prev = n_prev.transpose(1, 0, 2, 3)
    m_prev = m_prev.transpose(1, 0, 2)
    g = bt + m_prev[..., None]
    m_t = jnp.maximum(g, jnp.max(dlog, axis=-1))
    s = jnp.einsum('bnqhd,bnshd->bnhqs', qc, kc) * jnp.exp(dlog - m_t[..., None])
    w_inter = jnp.exp(g - m_t)
    num = (jnp.einsum('bnhqs,bnshe->bnhqe', s, vc)
           + w_inter[..., None] * jnp.einsum('bnqhd,bnhde->bnhqe', qc, c_prev))
    den = jnp.sum(s, axis=-1) + w_inter * jnp.einsum('bnqhd,bnhd->bnhq', qc, n_prev)
    out = num / jnp.maximum(jnp.abs(den), jnp.exp(-m_t))[..., None]
    return out.transpose(0, 1, 3, 2, 4).reshape(b, lp, h, d)


def centred_dwconv(x, w, bias):
    out = lax.conv_general_dilated(x, w[:, None, :].astype(x.dtype), window_strides=(1,),
                                   padding=[(CONV_W // 2, CONV_W // 2)],
                                   dimension_numbers=('NWC', 'WIO', 'NWC'),
                                   feature_group_count=x.shape[-1])
    return out + bias.astype(x.dtype)


def even_mixer(h, w_in, w_out, q_norm, k_norm, lam_re, lam_im, log_dt, b_re, b_im, c_re, c_im,
               d_skip, glu_w, glu_b, ang_row, ang_col):
    b, l, _ = h.shape
    q, k, v, u = jnp.split(h @ w_in, [ATT_WIDTH, ATT_WIDTH + ATT_KV_WIDTH, ATT_WIDTH + 2 * ATT_KV_WIDTH], axis=-1)
    q = axial_rope(rms_norm(q.reshape(b, l, ATT_HEADS, HEAD_DIM), q_norm), ang_row, ang_col)
    k = axial_rope(rms_norm(k.reshape(b, l, ATT_KV_HEADS, HEAD_DIM), k_norm), ang_row, ang_col)
    att = grid_attention(q, k, v.reshape(b, l, ATT_KV_HEADS, HEAD_DIM))
    ssm = s5_mixer(u, lam_re, lam_im, log_dt, b_re, b_im, c_re, c_im, d_skip, glu_w, glu_b)
    return jnp.concatenate([att.astype(jnp.float32), ssm], axis=-1).astype(h.dtype) @ w_out


def odd_mixer(h, w_in, w_out, ret_log_decay, ret_norm, conv_w, conv_b, wq, wk, wv, gate_b, ml_norm, ang_lin):
    b, l, _ = h.shape
    f32 = jnp.float32
    pad = (-l) % BLOCK
    splits = [RET_WIDTH, 2 * RET_WIDTH, 3 * RET_WIDTH, 4 * RET_WIDTH,
              4 * RET_WIDTH + ML_WIDTH, 4 * RET_WIDTH + 2 * ML_WIDTH]
    rq, rk, rv, rg, mu, mo, gates = jnp.split(h @ w_in, splits, axis=-1)

    rq = pad_front(rope(rq.reshape(b, l, RET_HEADS, HEAD_DIM), ang_lin) * HEAD_DIM ** -0.5, pad)
    rk = pad_front(rope(rk.reshape(b, l, RET_HEADS, HEAD_DIM), ang_lin), pad)
    rv = pad_front(rv.reshape(b, l, RET_HEADS, HEAD_DIM), pad)
    log_gamma = -jnp.abs(ret_log_decay.astype(f32))
    ret = (retention_direction(rq, rk, rv, log_gamma[0], False)
           + flip_t(retention_direction(flip_t(rq), flip_t(rk), flip_t(rv), log_gamma[1], True)))
    ret = head_layer_norm(ret[:, pad:], ret_norm) * jax.nn.silu(rg.astype(f32))

    uc = jax.nn.silu(centred_dwconv(mu, conv_w, conv_b))
    mq = pad_front(jnp.einsum('blhd,hde->blhe', uc.reshape(b, l, ML_HEADS, HEAD_DIM), wq), pad)
    mk = pad_front(jnp.einsum('blhd,hde->blhe', uc.reshape(b, l, ML_HEADS, HEAD_DIM), wk) * HEAD_DIM ** -0.5, pad)
    mv = pad_front(jnp.einsum('blhd,hde->blhe', mu.reshape(b, l, ML_HEADS, HEAD_DIM), wv), pad)
    g = gates.astype(f32).reshape(b, l, 4, ML_HEADS) + gate_b.astype(f32)
    valid = (jnp.arange(l + pad) >= pad)[None, :, None, None]
    log_i = jnp.where(valid, pad_front(g[:, :, 0::2], pad), NEG_GATE)
    log_f = jnp.where(valid, pad_front(jax.nn.log_sigmoid(g[:, :, 1::2]), pad), 0.0)
    hm = (mlstm_direction(mq, mk, mv, log_i[:, :, 0], log_f[:, :, 0])
          + flip_t(mlstm_direction(flip_t(mq), flip_t(mk), flip_t(mv),
                                   flip_t(log_i[:, :, 1]), flip_t(log_f[:, :, 1]))))
    hm = head_layer_norm(hm[:, pad:], ml_norm) * jax.nn.sigmoid(mo.astype(f32))
    return jnp.concatenate([ret, hm], axis=-1).astype(h.dtype) @ w_out


def setup_inputs(seed: int = 0) -> dict:
    key = jax.random.key(seed)
    ks = iter(jax.random.split(key, 32))
    f32 = jnp.float32

    def nrm(shape, scale):
        return scale * jax.random.normal(next(ks), shape, f32)

    lam_im_base = jnp.pi * jnp.arange(S5_STATE, dtype=f32)
    ret_base = jnp.log(1.0 - 2.0 ** (-5.0 - jnp.arange(RET_HEADS, dtype=f32)))
    forget_base = jnp.linspace(3.0, 6.0, ML_HEADS, dtype=f32)
    gate_rows = jnp.array([0.0, 1.0, 0.0, 1.0], f32)
    return {
        'x': nrm((BATCH, SEQ, D_MODEL), 1.0),
        'meta_tokens': nrm((N_META, D_MODEL), 1.0),
        'norm_gains': 1.0 + nrm((DEPTH, 4, D_MODEL), 0.02),
        'mlp_w1': nrm((DEPTH, D_MODEL, D_FF), D_MODEL ** -0.5),
        'mlp_w2': nrm((DEPTH, D_FF, D_MODEL), D_FF ** -0.5),
        'even_w_in': nrm((N_EVEN, D_MODEL, EVEN_IN), D_MODEL ** -0.5),
        'even_w_out': nrm((N_EVEN, MIX_WIDTH, D_MODEL), MIX_WIDTH ** -0.5),
        'att_q_norm': 1.0 + nrm((N_EVEN, HEAD_DIM), 0.02),
        'att_k_norm': 1.0 + nrm((N_EVEN, HEAD_DIM), 0.02),
        's5_lam_re': -0.5 + nrm((N_EVEN, 2, S5_GROUPS, S5_STATE), 0.01),
        's5_lam_im': lam_im_base + nrm((N_EVEN, 2, S5_GROUPS, S5_STATE), 0.01),
        's5_log_dt': jax.random.uniform(next(ks), (N_EVEN, 2, S5_GROUPS), f32,
                                        minval=math.log(1e-3), maxval=math.log(1e-1)),
        's5_b_re': nrm((N_EVEN, 2, S5_GROUPS, S5_STATE, S5_GROUP), (2 * S5_GROUP) ** -0.5),
        's5_b_im': nrm((N_EVEN, 2, S5_GROUPS, S5_STATE, S5_GROUP), (2 * S5_GROUP) ** -0.5),
        's5_c_re': nrm((N_EVEN, 2, S5_GROUPS, S5_GROUP, S5_STATE), S5_STATE ** -0.5),
        's5_c_im': nrm((N_EVEN, 2, S5_GROUPS, S5_GROUP, S5_STATE), S5_STATE ** -0.5),
        's5_d': nrm((N_EVEN, S5_GROUPS, S5_GROUP), 1.0),
        's5_glu_w': nrm((N_EVEN, S5_WIDTH, S5_WIDTH), S5_WIDTH ** -0.5),
        's5_glu_b': nrm((N_EVEN, S5_WIDTH), 0.02),
        'odd_w_in': nrm((N_ODD, D_MODEL, ODD_IN), D_MODEL ** -0.5),
        'odd_w_out': nrm((N_ODD, MIX_WIDTH, D_MODEL), MIX_WIDTH ** -0.5),
        'ret_log_decay': ret_base * (1.0 + nrm((N_ODD, 2, RET_HEADS), 0.05)),
        'ret_norm': 1.0 + nrm((N_ODD, RET_WIDTH), 0.02),
        'ml_conv_w': nrm((N_ODD, CONV_W, ML_WIDTH), CONV_W ** -0.5),
        'ml_conv_b': nrm((N_ODD, ML_WIDTH), 0.02),
        'ml_wq': nrm((N_ODD, ML_HEADS, HEAD_DIM, HEAD_DIM), HEAD_DIM ** -0.5),
        'ml_wk': nrm((N_ODD, ML_HEADS, HEAD_DIM, HEAD_DIM), HEAD_DIM ** -0.5),
        'ml_wv': nrm((N_ODD, ML_HEADS, HEAD_DIM, HEAD_DIM), HEAD_DIM ** -0.5),
        'ml_gate_b': nrm((N_ODD, 4, ML_HEADS), 0.1) + gate_rows[None, :, None] * forget_base[None, None, :],
        'ml_norm': 1.0 + nrm((N_ODD, ML_WIDTH), 0.02),
    }


def reference(x, meta_tokens, norm_gains, mlp_w1, mlp_w2, even_w_in, even_w_out, att_q_norm, att_k_norm,
              s5_lam_re, s5_lam_im, s5_log_dt, s5_b_re, s5_b_im, s5_c_re, s5_c_im, s5_d, s5_glu_w, s5_glu_b,
              odd_w_in, odd_w_out, ret_log_decay, ret_norm, ml_conv_w, ml_conv_b, ml_wq, ml_wk, ml_wv,
              ml_gate_b, ml_norm):
    b, n_tok, d_model = x.shape
    h = jnp.concatenate([jnp.broadcast_to(meta_tokens.astype(x.dtype)[None], (b, N_META, d_model)), x], axis=1)
    l = h.shape[1]
    row, col = grid_positions(n_tok)
    f_axis = rope_freqs(HEAD_DIM // 2)
    ang_row = row[:, None] * f_axis[None, :]
    ang_col = col[:, None] * f_axis[None, :]
    ang_lin = jnp.arange(l, dtype=jnp.float32)[:, None] * rope_freqs(HEAD_DIM)[None, :]

    for i in range(DEPTH):
        j = i // 2
        hn = rms_norm(h, norm_gains[i, 0])
        if i % 2 == 0:
            mix = even_mixer(hn, even_w_in[j], even_w_out[j], att_q_norm[j], att_k_norm[j],
                             s5_lam_re[j], s5_lam_im[j], s5_log_dt[j], s5_b_re[j], s5_b_im[j],
                             s5_c_re[j], s5_c_im[j], s5_d[j], s5_glu_w[j], s5_glu_b[j], ang_row, ang_col)
        else:
            mix = odd_mixer(hn, odd_w_in[j], odd_w_out[j], ret_log_decay[j], ret_norm[j], ml_conv_w[j],
                            ml_conv_b[j], ml_wq[j], ml_wk[j], ml_wv[j], ml_gate_b[j], ml_norm[j], ang_lin)
        h = h + rms_norm(mix, norm_gains[i, 1])
        h = h + rms_norm(sq_relu_mlp(rms_norm(h, norm_gains[i, 2]), mlp_w1[i], mlp_w2[i]), norm_gains[i, 3])
    return h[:, N_META:]
```

```cpp
#include <hip/hip_runtime.h>
#include <hip/hip_cooperative_groups.h>
#include <stdint.h>
#include <cstdio>
namespace cg = cooperative_groups;

typedef unsigned short bf16_t;
typedef short bf16x8 __attribute__((ext_vector_type(8)));
typedef short s16x4 __attribute__((ext_vector_type(4)));
typedef float f32x2 __attribute__((ext_vector_type(2)));
typedef float f32x4 __attribute__((ext_vector_type(4)));
typedef float f32x16 __attribute__((ext_vector_type(16)));
typedef unsigned u32x2 __attribute__((ext_vector_type(2)));
typedef unsigned u32x4 __attribute__((ext_vector_type(4)));
#define LAS __attribute__((address_space(3)))
#define DEVI __device__ __forceinline__

constexpr int NB = 8, LSEQ = 2064, NTOK = 16512, MP = 16640, NREAL = 16384, DM = 2048, DFF = 8192;
constexpr int LPAD = 2176;
constexpr int QROWS = 6400;
constexpr float EPS = 1e-6f;

constexpr size_t U_ = 34078720ull;
constexpr size_t W_W1T = 0, W_W2T = 33554432ull, W_WINT = 67108864ull;
constexpr size_t W_WOUT0 = W_WINT + 12582912ull, W_GLUT = W_WOUT0 + 8388608ull, W_S5E = W_GLUT + 524288ull, W_S5WY = W_S5E + 4194304ull,
                 W_APOW = W_S5WY + 8388608ull, W_BBAR = W_APOW + 557056ull, W_KD = W_BBAR + 524288ull;
constexpr size_t W_WOUT1 = W_WINT + 26214400ull, W_MLW = W_WOUT1 + 8388608ull;
constexpr size_t TBL = 104857600ull;
constexpr size_t T_ROPEL = TBL, T_ROPEA = T_ROPEL + 1056768ull, T_HMETA = T_ROPEA + 1056768ull, T_GATES = T_HMETA + 2097152ull,
                 T_GA = T_GATES + 2129920ull, T_GPM = T_GA + 1114112ull, T_GBT = T_GPM + 1114112ull, T_CTR = T_GBT + 1114112ull;
constexpr size_t AR = TBL + 10485760ull;
constexpr size_t A_X = AR, A_MID = AR + 2 * U_;
constexpr size_t A_PROJ0 = AR + 2 * U_, A_QB = AR + 5 * U_, A_KB = A_QB + 54525952ull, A_VB = A_KB + 18743296ull, A_MIXIN0 = A_VB + 18743296ull,
                 A_A2 = AR + 10 * U_, A_S = A_X, A_YS = A_X + 42598400ull;
constexpr size_t A_RQ = AR + 2 * U_, A_RK = AR + 3 * U_, A_RV = AR + 4 * U_, A_RG = AR + 5 * U_, A_MU = AR + 6 * U_, A_MO = AR + 7 * U_,
                 A_MQKV = AR + 8 * U_, A_T0 = AR, A_T1 = AR + U_, A_T2 = A_MU, A_T3 = AR + 11 * U_, A_UCMU = AR, A_MIXIN1 = A_RQ;
constexpr size_t A_PT = AR + 10 * U_;
constexpr size_t WS_NEED = AR + 12 * U_;
static_assert(A_MIXIN0 + 2 * U_ <= AR + 10 * U_, "layer0 map");
static_assert(T_CTR + 16384 <= AR, "tbl map");

struct Params { const float* in[30]; float* out; unsigned char* ws; };

typedef _Float16 f16x2 __attribute__((ext_vector_type(2)));
typedef _Float16 f16x8 __attribute__((ext_vector_type(8)));
#define H8(x) __builtin_bit_cast(f16x8, (x))
DEVI unsigned cvtpk(float lo, float hi) { f16x2 v = {(_Float16)lo, (_Float16)hi}; return __builtin_bit_cast(unsigned, v); }
DEVI bf16_t f2bf(float f) { return __builtin_bit_cast(unsigned short, (_Float16)f); }
DEVI float bf2f(bf16_t b) { return (float)__builtin_bit_cast(_Float16, b); }
DEVI float bflo(unsigned w) { return (float)__builtin_bit_cast(f16x2, w)[0]; }
DEVI float bfhi(unsigned w) { return (float)__builtin_bit_cast(f16x2, w)[1]; }
DEVI int row_of(int b, int l) { return l < 16 ? NREAL + b * 16 + l : b * 2048 + (l - 16); }
DEVI void bl_of(int r, int& b, int& l) { if (r < NREAL) { b = r >> 11; l = 16 + (r & 2047); } else { const int m = r - NREAL; b = m >> 4; l = m & 15; } }
DEVI float* hrow(const Params& p, int r) { return r < NREAL ? p.out + (size_t)r * DM : (float*)(p.ws + T_HMETA) + (size_t)(r - NREAL) * DM; }
DEVI float wave_sum(float v) {
#pragma unroll
    for (int o = 32; o > 0; o >>= 1) v += __shfl_xor(v, o);
    return v;
}
DEVI float sigmoidf_(float x) { return 1.f / (1.f + __expf(-x)); }
DEVI void sincos_rr(float x, float& s, float& c) {
    const float k = rintf(x * 0.15915494309189535f);
    float r = fmaf(-k, 6.2831854820251465f, x); r = fmaf(k, 1.7484555e-7f, r);
    s = __sinf(r); c = __cosf(r);
}
DEVI float gelu_tanh(float x) { const float u = 0.7978845608028654f * (x + 0.044715f * x * x * x); const float t = 1.f - 2.f / (1.f + __expf(2.f * u)); return 0.5f * x * (1.f + t); }

namespace pg8 {
constexpr int BM = 256, BK = 64, HALF = 128, HTB = HALF * BK * 2, STAGE_BYTES = 8 * HTB, NXCD = 8, WGM = 8;
DEVI int lds_byte(int r, int c) { const int st = (r >> 4) * 2 + (c >> 5), rr = r & 15, cc = c & 31, ob = rr * 64 + cc * 2; return st * 1024 + (ob ^ (((ob >> 9) & 1) << 5)); }
DEVI void stage_rc(int b, int& R, int& C) { const int st = b / 1024, sb = b % 1024, swz = sb ^ (((sb >> 9) & 1) << 5); R = (st >> 1) * 16 + swz / 64; C = (st & 1) * 32 + (swz % 64) / 2; }
DEVI int perm32(int rho) { const int n = rho >> 4, i = rho & 15; return 8 * (i >> 2) + 4 * n + (i & 3); }
struct Unit { int pm, pn, bz; };
struct Gemm { const bf16_t* A; const bf16_t* Bt; int lda, ldb, K, nM, nN, nB; size_t sA, sB; };
struct Order {
    int nM, nN, nwg, tot, G, c;
    DEVI void init(const Gemm& g, int G_, int c_) { nM = g.nM; nN = g.nN; nwg = nM * nN; tot = nwg * g.nB; G = G_; c = c_; }
    DEVI bool next(int i, Unit& u) const {
        const long L = (long)i * G + c; if (L >= tot) return false;
        u.bz = (int)(L / nwg); int wgid = (int)(L % nwg);
        { const int q = nwg / NXCD, r = nwg % NXCD, xcd = wgid % NXCD, off = wgid / NXCD; wgid = (xcd < r ? xcd * (q + 1) : r * (q + 1) + (xcd - r) * q) + off; }
        const int nig = WGM * nN, gid = wgid / nig, fm = gid * WGM, gsz = (nM - fm) < WGM ? (nM - fm) : WGM;
        u.pm = fm + ((wgid % nig) % gsz); u.pn = (wgid % nig) / gsz; return true;
    }
};
template <class Epi>
DEVI void gemm_phase(LAS unsigned char* lds, const Gemm g, const Epi& E) {
    const int tid = threadIdx.x, wid = __builtin_amdgcn_readfirstlane(tid >> 6), lane = tid & 63, wr = wid >> 2, wc = wid & 3, fr = lane & 15, fq = lane >> 4;
    const int K = g.K, nt = K / BK;
    Order S; S.init(g, (int)gridDim.x, (int)blockIdx.x);
    unsigned voffA[2], voffB[2];
#pragma unroll
    for (int i = 0; i < 2; ++i) { int R, C; stage_rc(tid * 16 + i * 8192, R, C); const int Rb = Epi::PERM ? ((R & ~31) + perm32(R & 31)) : R;
        voffA[i] = (unsigned)(R * g.lda + C) * 2u; voffB[i] = (unsigned)(Rb * g.ldb + C) * 2u; }
    const size_t kstep = (size_t)(BK * 2);
    const size_t hstepA = (size_t)HALF * g.lda * 2, hstepB = (size_t)HALF * g.ldb * 2;
    const unsigned ldsw = (unsigned)wid * 1024u;
    const int aoff = lds_byte(wr * 64 + fr, fq * 8), boff = lds_byte(wc * 32 + fr, fq * 8);
#define PG8_SA(b, h) (((b) * 2 + (h)) * HTB)
#define PG8_SB(b, h) ((4 + (b) * 2 + (h)) * HTB)
#define PG8_STAGE(bufoff, gbase, voff) do { _Pragma("unroll") for (int _i = 0; _i < 2; ++_i) \
        __builtin_amdgcn_global_load_lds((const unsigned*)((const char*)(gbase) + (voff)[_i]), (LAS unsigned*)(lds + (bufoff) + ldsw + _i * 8192), 16, 0, 0); } while (0)
#define PG8_LDA(dst, b, h) do { _Pragma("unroll") for (int m = 0; m < 4; ++m) _Pragma("unroll") for (int k = 0; k < 2; ++k) dst[m][k] = *(const LAS bf16x8*)(lds + PG8_SA(b, h) + aoff + m * 2048 + k * 1024); } while (0)
#define PG8_LDB(dst, b, h) do { _Pragma("unroll") for (int n = 0; n < 2; ++n) _Pragma("unroll") for (int k = 0; k < 2; ++k) dst[n][k] = *(const LAS bf16x8*)(lds + PG8_SB(b, h) + boff + n * 2048 + k * 1024); } while (0)
#define PG8_MMA(ai, bj, At, Bt) do { __builtin_amdgcn_s_setprio(1); _Pragma("unroll") for (int m = 0; m < 4; ++m) _Pragma("unroll") for (int n = 0; n < 2; ++n) _Pragma("unroll") for (int k = 0; k < 2; ++k) \
        acc[ai][bj][m][n] = __builtin_amdgcn_mfma_f32_16x16x32_f16(H8(Bt[n][k]), H8(At[m][k]), acc[ai][bj][m][n], 0, 0, 0); __builtin_amdgcn_s_setprio(0); } while (0)
#define PG8_WAIT_V(n) asm volatile("s_waitcnt vmcnt(" #n ")" ::: "memory")
#define PG8_WAIT_L(n) asm volatile("s_waitcnt lgkmcnt(" #n ")" ::: "memory")
#define PG8_BAR __builtin_amdgcn_s_barrier()
#define PG8_SCHED __builtin_amdgcn_sched_barrier(0)
    Unit cur, nxt; int ui = 0;
    if (!S.next(0, cur)) return;
    f32x4 acc[2][2][4][2];
#pragma unroll
    for (int a = 0; a < 2; ++a)
#pragma unroll
        for (int b = 0; b < 2; ++b)
#pragma unroll
            for (int m = 0; m < 4; ++m)
#pragma unroll
                for (int n = 0; n < 2; ++n) acc[a][b][m][n] = (f32x4){0.f, 0.f, 0.f, 0.f};
    bf16x8 At[4][2], B0[2][2], B1[2][2];
    const char* cA = (const char*)g.A + ((size_t)cur.bz * g.sA) * 2 + (size_t)cur.pm * 2 * hstepA;
    const char* cB = (const char*)g.Bt + ((size_t)cur.bz * g.sB) * 2 + (size_t)cur.pn * 2 * hstepB;
    PG8_STAGE(PG8_SB(0, 0), cB, voffB); PG8_STAGE(PG8_SA(0, 0), cA, voffA); PG8_STAGE(PG8_SB(0, 1), cB + hstepB, voffB); PG8_STAGE(PG8_SA(0, 1), cA + hstepA, voffA);
    if (wr == 1) PG8_BAR;
    PG8_WAIT_V(4); PG8_BAR;
    PG8_STAGE(PG8_SB(1, 0), cB + kstep, voffB); PG8_STAGE(PG8_SA(1, 0), cA + kstep, voffA); PG8_STAGE(PG8_SB(1, 1), cB + hstepB + kstep, voffB);
    PG8_WAIT_V(6); PG8_BAR;
    for (;;) {
        const bool has_next = S.next(ui + 1, nxt);
        const char* nA = has_next ? (const char*)g.A + ((size_t)nxt.bz * g.sA) * 2 + (size_t)nxt.pm * 2 * hstepA : cA;
        const char* nB = has_next ? (const char*)g.Bt + ((size_t)nxt.bz * g.sB) * 2 + (size_t)nxt.pn * 2 * hstepB : cB;
#pragma unroll 1
        for (int t = 0; t < nt; t += 2) {
            const bool last = (t == nt - 2);
            const char* a1 = cA + (size_t)(t + 1) * kstep;
            const char* a2 = last ? nA : cA + (size_t)(t + 2) * kstep; const char* b2 = last ? nB : cB + (size_t)(t + 2) * kstep;
            const char* a3 = a2 + kstep; const char* b3 = b2 + kstep;
            PG8_LDB(B0, 0, 0); PG8_SCHED; PG8_LDA(At, 0, 0); PG8_STAGE(PG8_SA(1, 1), a1 + hstepA, voffA);
            PG8_WAIT_L(8); PG8_BAR; PG8_WAIT_L(0); PG8_MMA(0, 0, At, B0); PG8_BAR; PG8_SCHED;
            PG8_LDB(B1, 0, 1); PG8_STAGE(PG8_SB(0, 0), b2, voffB);
            PG8_BAR; PG8_WAIT_L(0); PG8_MMA(0, 1, At, B1); PG8_BAR;
            PG8_LDA(At, 0, 1); PG8_STAGE(PG8_SA(0, 0), a2, voffA);
            PG8_BAR; PG8_WAIT_L(0); PG8_MMA(1, 0, At, B0); PG8_BAR; PG8_SCHED;
            PG8_STAGE(PG8_SB(0, 1), b2 + hstepB, voffB);
            PG8_WAIT_V(6); PG8_BAR; PG8_MMA(1, 1, At, B1); PG8_BAR;
            PG8_LDB(B0, 1, 0); PG8_SCHED; PG8_LDA(At, 1, 0); PG8_STAGE(PG8_SA(0, 1), a2 + hstepA, voffA);
            PG8_WAIT_L(8); PG8_BAR; PG8_WAIT_L(0); PG8_MMA(0, 0, At, B0); PG8_BAR; PG8_SCHED;
            PG8_LDB(B1, 1, 1); PG8_STAGE(PG8_SB(1, 0), b3, voffB);
            PG8_BAR; PG8_WAIT_L(0); PG8_MMA(0, 1, At, B1); PG8_BAR;
            PG8_LDA(At, 1, 1); PG8_STAGE(PG8_SA(1, 0), a3, voffA);
            PG8_BAR; PG8_WAIT_L(0); PG8_MMA(1, 0, At, B0); PG8_BAR; PG8_SCHED;
            PG8_STAGE(PG8_SB(1, 1), b3 + hstepB, voffB);
            PG8_WAIT_V(6); PG8_BAR; PG8_MMA(1, 1, At, B1); PG8_BAR;
        }
        E(acc, cur, wr, wc, fr, fq);
        if (!has_next) break;
#pragma unroll
        for (int a = 0; a < 2; ++a)
#pragma unroll
            for (int b = 0; b < 2; ++b)
#pragma unroll
                for (int m = 0; m < 4; ++m)
#pragma unroll
                    for (int n = 0; n < 2; ++n) acc[a][b][m][n] = (f32x4){0.f, 0.f, 0.f, 0.f};
        cur = nxt; cA = nA; cB = nB; ++ui;
    }
    PG8_WAIT_V(0);
    if (wr == 0) PG8_BAR;
    PG8_BAR;
#undef PG8_SA
#undef PG8_SB
#undef PG8_STAGE
#undef PG8_LDA
#undef PG8_LDB
#undef PG8_MMA
#undef PG8_WAIT_V
#undef PG8_WAIT_L
#undef PG8_BAR
#undef PG8_SCHED
}

template <class F> DEVI void epi8(const f32x4 (&acc)[2][2][4][2], const Unit& u, int wr, int wc, int fr, int fq, const F& f) {
    const int row0 = u.pm * BM + wr * 64 + fr, col0 = u.pn * BM + wc * 32 + 8 * fq;
#pragma unroll
    for (int ai = 0; ai < 2; ++ai)
#pragma unroll
        for (int m = 0; m < 4; ++m)
#pragma unroll
            for (int bj = 0; bj < 2; ++bj) f(row0 + ai * HALF + m * 16, col0 + bj * HALF, acc[ai][bj][m][0], acc[ai][bj][m][1]);
}
DEVI u32x4 pack8(f32x4 v0, f32x4 v1) { u32x4 w; w.x = cvtpk(v0[0], v0[1]); w.y = cvtpk(v0[2], v0[3]); w.z = cvtpk(v1[0], v1[1]); w.w = cvtpk(v1[2], v1[3]); return w; }

template <int ACT  > struct EpiBf16 {
    static constexpr bool PERM = true;
    bf16_t* O; int ldc;
    DEVI void operator()(const f32x4 (&acc)[2][2][4][2], const Unit& u, int wr, int wc, int fr, int fq) const {
        epi8(acc, u, wr, wc, fr, fq, [&](int row, int col, f32x4 v0, f32x4 v1) {
            if (ACT == 1) {
#pragma unroll
                for (int j = 0; j < 4; ++j) { const float a = fmaxf(v0[j], 0.f), b = fmaxf(v1[j], 0.f); v0[j] = a * a; v1[j] = b * b; } }
            *(u32x4*)(O + (size_t)row * ldc + col) = pack8(v0, v1); });
    }
};
struct EpiWin0 {
    static constexpr bool PERM = true;
    bf16_t* proj; bf16_t* a2;
    DEVI void operator()(const f32x4 (&acc)[2][2][4][2], const Unit& u, int wr, int wc, int fr, int fq) const {
        epi8(acc, u, wr, wc, fr, fq, [&](int row, int col, f32x4 v0, f32x4 v1) {
            const u32x4 w = pack8(v0, v1);
            if (col < 2560) { *(u32x4*)(proj + (size_t)row * 2560 + col) = w; }
            else if (row < NTOK) {
                int b, l; bl_of(row, b, l); const int cid = b * 129 + (l >> 4), i = l & 15, cc = col - 2560, gg = cc >> 4, h8 = cc & 15;
                *(u32x4*)(a2 + ((size_t)gg * 1280 + cid) * 512 + i * 16 + h8) = w; } });
    }
};
struct EpiF32 {
    static constexpr bool PERM = false;
    float* C; int ldc; size_t sC;
    DEVI void operator()(const f32x4 (&acc)[2][2][4][2], const Unit& u, int wr, int wc, int fr, int fq) const {
        const int row0 = u.pm * BM + wr * 64 + fr, col0 = u.pn * BM + wc * 32 + 4 * fq; float* Cb = C + (size_t)u.bz * sC;
#pragma unroll
        for (int ai = 0; ai < 2; ++ai)
#pragma unroll
            for (int m = 0; m < 4; ++m) { float* rowp = Cb + (size_t)(row0 + ai * HALF + m * 16) * ldc + col0;
#pragma unroll
                for (int bj = 0; bj < 2; ++bj)
#pragma unroll
                    for (int n = 0; n < 2; ++n) *(f32x4*)(rowp + bj * HALF + n * 16) = acc[ai][bj][m][n]; }
    }
};
struct EpiPart {
    static constexpr bool PERM = false;
    float* P;
    DEVI void operator()(const f32x4 (&acc)[2][2][4][2], const Unit& u, int wr, int wc, int fr, int fq) const {
        const int row0 = wr * 64 + fr, col0 = u.pn * BM + wc * 32 + 4 * fq; float* Pb = P + (size_t)u.bz * 128 * 2048;
#pragma unroll
        for (int m = 0; m < 4; ++m) { float* rowp = Pb + (size_t)(row0 + m * 16) * 2048 + col0;
#pragma unroll
            for (int bj = 0; bj < 2; ++bj)
#pragma unroll
                for (int n = 0; n < 2; ++n) *(f32x4*)(rowp + bj * HALF + n * 16) = acc[0][bj][m][n]; }
    }
};
struct EpiS5Y {
    static constexpr bool PERM = true;
    bf16_t* ys;
    DEVI void operator()(const f32x4 (&acc)[2][2][4][2], const Unit& u, int wr, int wc, int fr, int fq) const {
        epi8(acc, u, wr, wc, fr, fq, [&](int cid, int col, f32x4 v0, f32x4 v1) {
            if (cid < 1032) { const int b = cid / 129, c = cid - b * 129, i = col >> 4, h8 = col & 15; const int row = row_of(b, c * 16 + i);
#pragma unroll
                for (int j = 0; j < 4; ++j) { v0[j] = gelu_tanh(v0[j]); v1[j] = gelu_tanh(v1[j]); }
                *(u32x4*)(ys + (size_t)row * 512 + u.bz * 16 + h8) = pack8(v0, v1); } });
    }
};
struct EpiGlu {
    static constexpr bool PERM = true;
    const bf16_t* ys; const float* bias; bf16_t* mixin;
    DEVI void operator()(const f32x4 (&acc)[2][2][4][2], const Unit& u, int wr, int wc, int fr, int fq) const {
        epi8(acc, u, wr, wc, fr, fq, [&](int row, int col, f32x4 v0, f32x4 v1) {
            const u32x4 y = *(const u32x4*)(ys + (size_t)row * 512 + col); const f32x4 b0 = *(const f32x4*)(bias + col), b1 = *(const f32x4*)(bias + col + 4);
            const float yy[8] = {bflo(y.x), bfhi(y.x), bflo(y.y), bfhi(y.y), bflo(y.z), bfhi(y.z), bflo(y.w), bfhi(y.w)};
#pragma unroll
            for (int j = 0; j < 4; ++j) { v0[j] = yy[j] * sigmoidf_(v0[j] + b0[j]); v1[j] = yy[4 + j] * sigmoidf_(v1[j] + b1[j]); }
            *(u32x4*)(mixin + (size_t)row * 2048 + 1536 + col) = pack8(v0, v1); });
    }
};
struct EpiWin1 {
    static constexpr bool PERM = true;
    bf16_t* base; float* gates;
    DEVI void operator()(const f32x4 (&acc)[2][2][4][2], const Unit& u, int wr, int wc, int fr, int fq) const {
        epi8(acc, u, wr, wc, fr, fq, [&](int row, int col, f32x4 v0, f32x4 v1) {
            if (col < 6144) { const int t = col >> 10; *(u32x4*)(base + (size_t)t * (U_ / 2) + (size_t)row * 1024 + (col & 1023)) = pack8(v0, v1); }
            else if (col < 6176) { float* gp = gates + (size_t)row * 32 + (col - 6144); *(f32x4*)gp = v0; *(f32x4*)(gp + 4) = v1; } });
    }
};
struct EpiMqkv {
    static constexpr bool PERM = true;
    bf16_t* O;
    DEVI void operator()(const f32x4 (&acc)[2][2][4][2], const Unit& u, int wr, int wc, int fr, int fq) const {
        const int row0 = u.pm * BM + wr * 64 + fr, col0 = u.pn * BM + wc * 32 + 8 * fq;
        bf16_t* base = O + (size_t)row0 * 3072 + u.bz * 384 + col0;
        const int nbj = u.pn == 0 ? 2 : 1;
#pragma unroll
        for (int ai = 0; ai < 2; ++ai)
#pragma unroll
            for (int m = 0; m < 4; ++m)
#pragma unroll
                for (int bj = 0; bj < 2; ++bj) if (bj < nbj) *(u32x4*)(base + (size_t)(ai * HALF + m * 16) * 3072 + bj * HALF) = pack8(acc[ai][bj][m][0], acc[ai][bj][m][1]);
    }
};
}

DEVI void tcvt_job(const float* __restrict__ src, int R, int C, bf16_t* __restrict__ dst, int ldd, float* tile  , int bid = -1, int nb = 0) {
    const int tr = R / 64, tc = (C + 63) / 64, nt = tr * tc, tid = threadIdx.x;
    if (bid < 0) { bid = blockIdx.x; nb = gridDim.x; }
    for (int t0 = bid * 4; t0 < nt; t0 += nb * 4) {
        __syncthreads();
        f32x4 v[4][2];
#pragma unroll
        for (int q = 0; q < 4; ++q) { const int t = t0 + q; const int r0 = (t / tc) * 64, c0 = (t % tc) * 64;
#pragma unroll
            for (int k = 0; k < 2; ++k) { const int r = (tid >> 4) + 32 * k, c4 = (tid & 15) * 4;
                v[q][k] = (f32x4){0.f, 0.f, 0.f, 0.f};
                if (t < nt && c0 + c4 < C) v[q][k] = *(const f32x4*)(src + (size_t)(r0 + r) * C + c0 + c4); } }
#pragma unroll
        for (int q = 0; q < 4; ++q)
#pragma unroll
            for (int k = 0; k < 2; ++k) { const int r = (tid >> 4) + 32 * k, c4 = (tid & 15) * 4; float* tp = tile + q * 4160 + r * 65 + c4;
                tp[0] = v[q][k][0]; tp[1] = v[q][k][1]; tp[2] = v[q][k][2]; tp[3] = v[q][k][3]; }
        __syncthreads();
#pragma unroll
        for (int q = 0; q < 4; ++q) { const int t = t0 + q; const int r0 = (t / tc) * 64, c0 = (t % tc) * 64; const float* tq = tile + q * 4160;
            const int c = tid >> 3, r8 = (tid & 7) * 8;
            if (t < nt && c0 + c < C) { u32x4 w; w.x = cvtpk(tq[(r8 + 0) * 65 + c], tq[(r8 + 1) * 65 + c]); w.y = cvtpk(tq[(r8 + 2) * 65 + c], tq[(r8 + 3) * 65 + c]);
                w.z = cvtpk(tq[(r8 + 4) * 65 + c], tq[(r8 + 5) * 65 + c]); w.w = cvtpk(tq[(r8 + 6) * 65 + c], tq[(r8 + 7) * 65 + c]);
                *(u32x4*)(dst + (size_t)(c0 + c) * ldd + r0 + r8) = w; } }
    }
    __syncthreads();
}

DEVI void phase_init_h(const Params& p, const float* gain) {
    const int wid = threadIdx.x >> 6, lane = threadIdx.x & 63;
    bf16_t* X = (bf16_t*)(p.ws + A_X);
    for (int r = blockIdx.x * 8 + wid; r < NTOK; r += gridDim.x * 8) {
        int b, l; bl_of(r, b, l);
        const float* src = l < 16 ? p.in[1] + (size_t)l * DM : p.in[0] + ((size_t)b * 2048 + (l - 16)) * DM;
        float* hp = hrow(p, r);
        f32x4 v[8]; float ss = 0.f;
#pragma unroll
        for (int j = 0; j < 8; ++j) { v[j] = *(const f32x4*)(src + j * 256 + lane * 4); ss += v[j][0] * v[j][0] + v[j][1] * v[j][1] + v[j][2] * v[j][2] + v[j][3] * v[j][3]; }
        ss = wave_sum(ss); const float rs = rsqrtf(ss * (1.f / DM) + EPS);
#pragma unroll
        for (int j = 0; j < 8; ++j) { if (r >= NREAL) *(f32x4*)(hp + j * 256 + lane * 4) = v[j]; const f32x4 g = *(const f32x4*)(gain + j * 256 + lane * 4);
            u32x2 w; w.x = cvtpk(v[j][0] * rs * g[0], v[j][1] * rs * g[1]); w.y = cvtpk(v[j][2] * rs * g[2], v[j][3] * rs * g[3]);
            *(u32x2*)(X + (size_t)r * DM + j * 256 + lane * 4) = w; }
    }
}
template <int MODE> DEVI void phase_norm(const Params& p, int nrows, const float* g1, const float* g2, const float* PT = nullptr, int nsplit = 0, float addscale = 1.f, const float* hin = nullptr) {
    const int wid = threadIdx.x >> 6, lane = threadIdx.x & 63;
    bf16_t* X = (bf16_t*)(p.ws + A_X);
    for (int r = blockIdx.x * 8 + wid; r < nrows; r += gridDim.x * 8) {
        float* hp = hrow(p, r); bf16_t* xp = X + (size_t)r * DM;
        const float* hr = (hin && r < NREAL) ? hin + (size_t)r * DM : hp;
        float y[32]; float ss = 0.f;
        if (PT && r >= NREAL) {
#pragma unroll
            for (int j = 0; j < 32; ++j) y[j] = 0.f;
            for (int sp = 0; sp < nsplit; ++sp) { const float* pr = PT + ((size_t)sp * 128 + (r - NREAL)) * 2048;
#pragma unroll
                for (int j = 0; j < 4; ++j) { const f32x4 a = *(const f32x4*)(pr + j * 512 + lane * 8), bq = *(const f32x4*)(pr + j * 512 + lane * 8 + 4);
#pragma unroll
                    for (int e = 0; e < 4; ++e) { y[j * 8 + e] += a[e]; y[j * 8 + 4 + e] += bq[e]; } } }
        } else
#pragma unroll
        for (int j = 0; j < 4; ++j) { const u32x4 w = *(const u32x4*)(xp + j * 512 + lane * 8);
            y[j * 8 + 0] = bflo(w.x); y[j * 8 + 1] = bfhi(w.x); y[j * 8 + 2] = bflo(w.y); y[j * 8 + 3] = bfhi(w.y);
            y[j * 8 + 4] = bflo(w.z); y[j * 8 + 5] = bfhi(w.z); y[j * 8 + 6] = bflo(w.w); y[j * 8 + 7] = bfhi(w.w); }
#pragma unroll
        for (int j = 0; j < 32; ++j) ss += y[j] * y[j];
        ss = wave_sum(ss); const float rs = rsqrtf(ss * (1.f / DM) + EPS) * addscale;
        float s2 = 0.f;
#pragma unroll
        for (int j = 0; j < 4; ++j)
#pragma unroll
            for (int q = 0; q < 2; ++q) { const int c = j * 512 + lane * 8 + q * 4; const f32x4 hv = *(const f32x4*)(hr + c), gv = *(const f32x4*)(g1 + c);
#pragma unroll
                for (int e = 0; e < 4; ++e) { const float hn = hv[e] + y[j * 8 + q * 4 + e] * rs * gv[e]; y[j * 8 + q * 4 + e] = hn; s2 += hn * hn; } }
#pragma unroll
        for (int j = 0; j < 4; ++j)
#pragma unroll
            for (int q = 0; q < 2; ++q) { const int c = j * 512 + lane * 8 + q * 4; *(f32x4*)(hp + c) = (f32x4){y[j * 8 + q * 4], y[j * 8 + q * 4 + 1], y[j * 8 + q * 4 + 2], y[j * 8 + q * 4 + 3]}; }
        if (MODE == 0) {
            s2 = wave_sum(s2); const float r2 = rsqrtf(s2 * (1.f / DM) + EPS);
#pragma unroll
            for (int j = 0; j < 4; ++j) { const int c = j * 512 + lane * 8; const f32x4 ga = *(const f32x4*)(g2 + c), gb = *(const f32x4*)(g2 + c + 4);
                u32x4 w; w.x = cvtpk(y[j * 8] * r2 * ga[0], y[j * 8 + 1] * r2 * ga[1]); w.y = cvtpk(y[j * 8 + 2] * r2 * ga[2], y[j * 8 + 3] * r2 * ga[3]);
                w.z = cvtpk(y[j * 8 + 4] * r2 * gb[0], y[j * 8 + 5] * r2 * gb[1]); w.w = cvtpk(y[j * 8 + 6] * r2 * gb[2], y[j * 8 + 7] * r2 * gb[3]);
                *(u32x4*)(xp + c) = w; }
        }
    }
}

DEVI void phase_tables(const Params& p) {
    const int gt = blockIdx.x * 512 + threadIdx.x, gs = gridDim.x * 512;
    float* rl = (float*)(p.ws + T_ROPEL); float* ra = (float*)(p.ws + T_ROPEA);
    for (int i = gt; i < LSEQ * 64; i += gs) {
        const int l = i >> 6, j = i & 63; float s, c;
        const float fl = __expf(-(float)j * (1.f / 64.f) * 9.210340371976184f);
        sincos_rr((float)l * fl, s, c); rl[i * 2] = c; rl[i * 2 + 1] = s;
        const float fa = __expf(-(float)(j & 31) * (1.f / 32.f) * 9.210340371976184f);
        float pos; if (l < 16) pos = (j < 32) ? -1.f : (float)l; else { const int n = l - 16; pos = (j < 32) ? (float)(n >> 6) : (float)(n & 63); }
        sincos_rr(pos * fa, s, c); ra[i * 2] = c; ra[i * 2 + 1] = s;
    }
    float* ap = (float*)(p.ws + W_APOW); float* bb = (float*)(p.ws + W_BBAR);
    for (int i = gt; i < 32 * 2 * 64; i += gs) {
        const int pp = i & 63, dir = (i >> 6) & 1, g = i >> 7; const int li_ = (dir * 32 + g) * 64 + pp;
        const float lr = fminf(p.in[9][li_], -1e-4f), li = p.in[10][li_], dt = __expf(p.in[11][dir * 32 + g]);
        for (int d = 0; d <= 16; ++d) { float s, c; sincos_rr(li * dt * (float)d, s, c); const float e = __expf(lr * dt * (float)d);
            float* o = ap + ((((size_t)g * 2 + dir) * 17 + d) * 64 + pp) * 2; o[0] = e * c; o[1] = e * s; }
        float s, c; sincos_rr(li * dt, s, c); const float er = __expf(lr * dt), are = er * c, aim = er * s;
        const float nr = are - 1.f, den = lr * lr + li * li, cre = (nr * lr + aim * li) / den, cim = (aim * lr - nr * li) / den;
        for (int h = 0; h < 16; ++h) { const float br = p.in[12][(size_t)li_ * 16 + h], bi = p.in[13][(size_t)li_ * 16 + h];
            float* o = bb + ((((size_t)g * 2 + dir) * 64 + pp) * 16 + h) * 2; o[0] = cre * br - cim * bi; o[1] = cre * bi + cim * br; }
    }
}
DEVI void phase_s5_build(const Params& p) {
    const int gt = blockIdx.x * 512 + threadIdx.x, gs = gridDim.x * 512;
    const float* ap = (const float*)(p.ws + W_APOW); const float* bb = (const float*)(p.ws + W_BBAR);
    bf16_t* E = (bf16_t*)(p.ws + W_S5E);
    for (int i = gt; i < 32 * 256 * 256; i += gs) {
        const int k = i & 255, n = (i >> 8) & 255, g = i >> 16; const int dir = n >> 7, part = (n >> 6) & 1, pp = n & 63, j = k >> 4, h = k & 15;
        const int d = dir ? j : 15 - j;
        const float* a = ap + ((((size_t)g * 2 + dir) * 17 + d) * 64 + pp) * 2; const float* b = bb + ((((size_t)g * 2 + dir) * 64 + pp) * 16 + h) * 2;
        const float re = a[0] * b[0] - a[1] * b[1], im = a[0] * b[1] + a[1] * b[0];
        E[i] = f2bf(part ? im : re);
    }
    float* KD = (float*)(p.ws + W_KD);
    for (int i = gt; i < 32 * 2 * 16 * 256; i += gs) {
        const int hi = i & 15, ho = (i >> 4) & 15, d = (i >> 8) & 15, dir = (i >> 12) & 1, g = i >> 13;
        const float* a = ap + (((size_t)g * 2 + dir) * 17 + d) * 128; const float* b = bb + (((size_t)g * 2 + dir) * 64) * 32 + hi * 2;
        const float* cr = p.in[14] + (((size_t)dir * 32 + g) * 16 + ho) * 64; const float* ci = p.in[15] + (((size_t)dir * 32 + g) * 16 + ho) * 64;
        float v = 0.f;
        for (int pp = 0; pp < 64; ++pp) { const float are = a[pp * 2], aim = a[pp * 2 + 1], bre = b[pp * 32], bim = b[pp * 32 + 1];
            const float tre = are * bre - aim * bim, tim = are * bim + aim * bre; v += cr[pp] * tre - ci[pp] * tim; }
        KD[i] = v;
    }
}
DEVI void phase_s5_build2(const Params& p) {
    const int gt = blockIdx.x * 512 + threadIdx.x, gs = gridDim.x * 512;
    const float* ap = (const float*)(p.ws + W_APOW); const float* KD = (const float*)(p.ws + W_KD); bf16_t* Wy = (bf16_t*)(p.ws + W_S5WY);
    for (int i = gt; i < 32 * 256 * 512; i += gs) {
        const int k = i & 511, n = (i >> 9) & 255, g = i >> 17; const int ii = n >> 4, ho = n & 15; float v = 0.f;
        if (k < 256) { const int j = k >> 4, hi = k & 15;
            if (j <= ii) v += KD[((((size_t)g * 2 + 0) * 16 + (ii - j)) * 16 + ho) * 16 + hi];
            if (j >= ii) v += KD[((((size_t)g * 2 + 1) * 16 + (j - ii)) * 16 + ho) * 16 + hi];
            if (j == ii && hi == ho) v += p.in[16][g * 16 + ho];
        } else { const int kk = k - 256, dir = kk >> 7, part = (kk >> 6) & 1, pp = kk & 63; const int d = dir ? 16 - ii : ii + 1;
            const float* a = ap + ((((size_t)g * 2 + dir) * 17 + d) * 64 + pp) * 2;
            const float cr = p.in[14][(((size_t)dir * 32 + g) * 16 + ho) * 64 + pp], ci = p.in[15][(((size_t)dir * 32 + g) * 16 + ho) * 64 + pp];
            const float zre = cr * a[0] - ci * a[1], zim = cr * a[1] + ci * a[0]; v = part ? -zim : zre; }
        Wy[i] = f2bf(v);
    }
}
DEVI void phase_s5_scan(const Params& p) {
    const float* S = (const float*)(p.ws + A_S); bf16_t* A2 = (bf16_t*)(p.ws + A_A2); const float* ap = (const float*)(p.ws + W_APOW);
    for (int it = (int)blockIdx.x - 192; it >= 0 && it < 64; it += gridDim.x) {
        const int t = it * 512 + threadIdx.x; const int pp = t & 63, dir = (t >> 6) & 1, g = (t >> 7) & 31, b = t >> 12;
        const float* a = ap + ((((size_t)g * 2 + dir) * 17 + 16) * 64 + pp) * 2; const float are = a[0], aim = a[1];
        float xr = 0.f, xi = 0.f;
        const size_t rb = (size_t)g * 1280 + b * 129;
#pragma unroll 1
        for (int s0 = 0; s0 < 136; s0 += 8) {
            float sr[8], si[8];
#pragma unroll
            for (int k = 0; k < 8; ++k) { const int s = s0 + k; const int c = dir ? 128 - s : s; const bool ok = s < 129; const size_t cid = rb + (ok ? c : 0);
                sr[k] = ok ? S[cid * 256 + dir * 128 + pp] : 0.f; si[k] = ok ? S[cid * 256 + dir * 128 + 64 + pp] : 0.f; }
#pragma unroll
            for (int k = 0; k < 8; ++k) { const int s = s0 + k; const int c = dir ? 128 - s : s;
                if (s < 129) { bf16_t* xo = A2 + (rb + c) * 512 + 256 + dir * 128 + pp; xo[0] = f2bf(xr); xo[64] = f2bf(xi);
                    const float nr = are * xr - aim * xi + sr[k], ni = are * xi + aim * xr + si[k]; xr = nr; xi = ni; } }
        }
    }
}

DEVI void phase_qk(const Params& p) {
    const int wid = threadIdx.x >> 6, lane = threadIdx.x & 63;
    const bf16_t* proj = (const bf16_t*)(p.ws + A_PROJ0); bf16_t* Qb = (bf16_t*)(p.ws + A_QB); bf16_t* Kb = (bf16_t*)(p.ws + A_KB); bf16_t* Vb = (bf16_t*)(p.ws + A_VB);
    const float* ra = (const float*)(p.ws + T_ROPEA);
    const int t16 = lane & 15, sub = lane >> 4;
    for (int it0 = (blockIdx.x * 8 + wid) * 4; it0 < NTOK * 20; it0 += gridDim.x * 32) {
        const int it = it0 + sub; const int r = it / 20, hs = it - r * 20; int b, l; bl_of(r, b, l);
        const u32x4 w = *(const u32x4*)(proj + (size_t)r * 2560 + hs * 128 + t16 * 8);
        if (hs >= 16) { *(u32x4*)(Vb + (((size_t)b * 4 + (hs - 16)) * LPAD + l) * 128 + t16 * 8) = w; continue; }
        float x[8] = {bflo(w.x), bfhi(w.x), bflo(w.y), bfhi(w.y), bflo(w.z), bfhi(w.z), bflo(w.w), bfhi(w.w)};
        float ss = 0.f;
#pragma unroll
        for (int e = 0; e < 8; ++e) ss += x[e] * x[e];
        ss += __shfl_xor(ss, 8); ss += __shfl_xor(ss, 4); ss += __shfl_xor(ss, 2); ss += __shfl_xor(ss, 1);
        const float rs = rsqrtf(ss * (1.f / 128.f) + EPS);
        const float* gn = (hs < 12 ? p.in[7] : p.in[8]) + t16 * 8;
        const f32x4 g0 = *(const f32x4*)gn, g1 = *(const f32x4*)(gn + 4);
        const int jt = 32 * (t16 >> 3) + 8 * (t16 & 3);
        const float* cs = ra + ((size_t)l * 64 + jt) * 2;
        const bool lo = (t16 & 4) == 0;
        float o[8];
#pragma unroll
        for (int e = 0; e < 8; ++e) { const float y = x[e] * rs * (e < 4 ? g0[e] : g1[e - 4]); const float yp = __shfl_xor(y, 4);
            const float c = cs[2 * e], sn = cs[2 * e + 1]; o[e] = lo ? (y * c - yp * sn) : (yp * sn + y * c); }
        bf16_t* dst;
        if (hs < 12) { const int kv = hs / 3, gq = hs - kv * 3; dst = Qb + (((size_t)b * 4 + kv) * QROWS + gq * LSEQ + l) * 128; }
        else dst = Kb + (((size_t)b * 4 + (hs - 12)) * LPAD + l) * 128;
        u32x4 ow; ow.x = cvtpk(o[0], o[1]); ow.y = cvtpk(o[2], o[3]); ow.z = cvtpk(o[4], o[5]); ow.w = cvtpk(o[6], o[7]);
        *(u32x4*)(dst + t16 * 8) = ow;
    }
    for (int it = blockIdx.x * 512 + threadIdx.x; it < 32 * 112 * 16; it += gridDim.x * 512) {
        const int ch = it & 15, rr = (it >> 4) % 112, bk = it / (112 * 16);
        *(u32x4*)(Vb + ((size_t)bk * LPAD + LSEQ + rr) * 128 + ch * 8) = (u32x4){0u, 0u, 0u, 0u};
        *(u32x4*)(Kb + ((size_t)bk * LPAD + LSEQ + rr) * 128 + ch * 8) = (u32x4){0u, 0u, 0u, 0u};
    }
    for (int it = blockIdx.x * 512 + threadIdx.x; it < 32 * 208 * 16; it += gridDim.x * 512) {
        const int ch = it & 15, rr = (it >> 4) % 208, bk = it / (208 * 16);
        *(u32x4*)(Qb + ((size_t)bk * QROWS + 3 * LSEQ + rr) * 128 + ch * 8) = (u32x4){0u, 0u, 0u, 0u};
    }
}

namespace att {
constexpr int D = 128, NW = 8, QBLK = 32, KVBLK = 64, LDQ = 128, LDK = 128, NVALID = LSEQ;
constexpr float SCALE = 0.088388347648318440f, THR = 8.f;
constexpr size_t SHM_V = KVBLK * D * 2, SHM_K = KVBLK * D * 2, SHM_ATTN = 2 * SHM_V + 2 * SHM_K + NW * 64 * 4;
#define KSWZ(row, colB) ((row) * 256 + ((colB) ^ (((row) & 7) << 4)))
#define SBAR() __builtin_amdgcn_sched_barrier(0)
DEVI int crow(int r, int hi) { return (r & 3) + 8 * (r >> 2) + 4 * hi; }
DEVI void maskp(f32x16& p0, f32x16& p1, int key0, int hi) {
#pragma unroll
    for (int r = 0; r < 16; ++r) { if (key0 + crow(r, hi) >= NVALID) p0[r] = -1e30f; if (key0 + 32 + crow(r, hi) >= NVALID) p1[r] = -1e30f; }
}
DEVI void partialSM(f32x16& p0, f32x16& p1, float& m_reg, float& mn, float& alpha) {
    constexpr float C = SCALE * 1.4426950408889634f;
    float pmax = p0[0];
#pragma unroll
    for (int r = 1; r < 16; ++r) pmax = fmaxf(pmax, p0[r]);
#pragma unroll
    for (int r = 0; r < 16; ++r) pmax = fmaxf(pmax, p1[r]);
    { auto rr = __builtin_amdgcn_permlane32_swap(__float_as_uint(pmax), __float_as_uint(pmax), false, false);
      pmax = fmaxf(__uint_as_float(rr[0]), __uint_as_float(rr[1])); }
    if (__builtin_expect(__all(pmax - m_reg <= THR / SCALE), 1)) { mn = m_reg; alpha = 1.f; }
    else { mn = fmaxf(m_reg, pmax); alpha = __builtin_amdgcn_exp2f((m_reg - mn) * C); m_reg = mn; }
    const float mnC = -mn * C;
#pragma unroll
    for (int r = 0; r < 16; ++r) p0[r] = fmaf(p0[r], C, mnC);
#pragma unroll
    for (int r = 0; r < 16; ++r) p1[r] = fmaf(p1[r], C, mnC);
#pragma unroll
    for (int r = 0; r < 16; ++r) p0[r] = __builtin_amdgcn_exp2f(p0[r]);
}
DEVI void finishSM(f32x16& p0, f32x16& p1, float alpha, float& l_reg, bf16x8& pa0, bf16x8& pa1, bf16x8& pa2, bf16x8& pa3) {
#pragma unroll
    for (int r = 0; r < 16; ++r) p1[r] = __builtin_amdgcn_exp2f(p1[r]);
    float ps = 0;
#pragma unroll
    for (int r = 0; r < 16; ++r) ps += p0[r];
#pragma unroll
    for (int r = 0; r < 16; ++r) ps += p1[r];
    { auto rr = __builtin_amdgcn_permlane32_swap(__float_as_uint(ps), __float_as_uint(ps), false, false);
      ps = __uint_as_float(rr[0]) + __uint_as_float(rr[1]); }
    l_reg = l_reg * alpha + ps;
#define PK4(P, BASE, OUT) do { unsigned a0 = cvtpk(P[BASE + 0], P[BASE + 1]), a1 = cvtpk(P[BASE + 2], P[BASE + 3]);   \
    unsigned b0 = cvtpk(P[BASE + 4], P[BASE + 5]), b1 = cvtpk(P[BASE + 6], P[BASE + 7]);                              \
    auto r0 = __builtin_amdgcn_permlane32_swap(a0, b0, false, false); auto r1 = __builtin_amdgcn_permlane32_swap(a1, b1, false, false); \
    u32x4 w = {r0[0], r1[0], r0[1], r1[1]}; OUT = *reinterpret_cast<bf16x8*>(&w); } while (0)
    PK4(p0, 0, pa0); PK4(p0, 8, pa1); PK4(p1, 0, pa2); PK4(p1, 8, pa3);
#undef PK4
}
DEVI void qkt(f32x16& p0, f32x16& p1, const bf16_t* Ks, const bf16x8* qr, int r32, int hi) {
    p0 = f32x16{}; p1 = f32x16{};
#pragma unroll
    for (int d0 = 0; d0 < 8; ++d0) { const int cb = (d0 * 16 + hi * 8) * 2;
        bf16x8 b0 = *reinterpret_cast<const bf16x8*>((const char*)Ks + KSWZ(r32, cb));
        bf16x8 b1 = *reinterpret_cast<const bf16x8*>((const char*)Ks + KSWZ(32 + r32, cb));
        p0 = __builtin_amdgcn_mfma_f32_32x32x16_f16(H8(b0), H8(qr[d0]), p0, 0, 0, 0);
        p1 = __builtin_amdgcn_mfma_f32_32x32x16_f16(H8(b1), H8(qr[d0]), p1, 0, 0, 0); }
}
DEVI int v_st(int k, int c) { const int kk = (k & ~0xC) | ((k & 4) << 1) | ((k & 8) >> 1); return ((kk >> 3) * 4 + (c >> 5)) * 512 + ((kk & 7) * 32 + (c & 31)) * 2; }
DEVI int v_rd_base(int lane) { return ((lane & 3) << 3) | (((lane >> 2) & 3) << 6) | (((lane >> 4) & 1) << 5) | (((lane >> 5) & 1) << 8); }
constexpr int v_rd_off(int d0, int ks, int half) { return d0 * 512 + ks * 4096 + half * 2048; }
template <int OFF> DEVI s16x4 tr_read(int vb) { s16x4 r; asm volatile("ds_read_b64_tr_b16 %0, %1 offset:%2" : "=&v"(r) : "v"(vb), "i"(OFF) : "memory"); return r; }
template <int D0> DEVI void pv_one(f32x16& od, int vb, bf16x8 pa0, bf16x8 pa1, bf16x8 pa2, bf16x8 pa3) {
    const s16x4 l0 = tr_read<v_rd_off(D0, 0, 0)>(vb), h0 = tr_read<v_rd_off(D0, 0, 1)>(vb), l1 = tr_read<v_rd_off(D0, 1, 0)>(vb), h1 = tr_read<v_rd_off(D0, 1, 1)>(vb);
    const s16x4 l2 = tr_read<v_rd_off(D0, 2, 0)>(vb), h2 = tr_read<v_rd_off(D0, 2, 1)>(vb), l3 = tr_read<v_rd_off(D0, 3, 0)>(vb), h3 = tr_read<v_rd_off(D0, 3, 1)>(vb);
    asm volatile("s_waitcnt lgkmcnt(0)" ::: "memory"); SBAR();
#define PK(L, H) (bf16x8){L[0], L[1], L[2], L[3], H[0], H[1], H[2], H[3]}
    od = __builtin_amdgcn_mfma_f32_32x32x16_f16(H8(pa0), H8(PK(l0, h0)), od, 0, 0, 0);
    od = __builtin_amdgcn_mfma_f32_32x32x16_f16(H8(pa1), H8(PK(l1, h1)), od, 0, 0, 0);
    od = __builtin_amdgcn_mfma_f32_32x32x16_f16(H8(pa2), H8(PK(l2, h2)), od, 0, 0, 0);
    od = __builtin_amdgcn_mfma_f32_32x32x16_f16(H8(pa3), H8(PK(l3, h3)), od, 0, 0, 0);
#undef PK
}
DEVI void pv_d0(f32x16* o, int vb, bf16x8 pa0, bf16x8 pa1, bf16x8 pa2, bf16x8 pa3) {
    pv_one<0>(o[0], vb, pa0, pa1, pa2, pa3); pv_one<1>(o[1], vb, pa0, pa1, pa2, pa3); pv_one<2>(o[2], vb, pa0, pa1, pa2, pa3); pv_one<3>(o[3], vb, pa0, pa1, pa2, pa3);
}
DEVI void attn_body(const bf16_t* __restrict__ Qb, const bf16_t* __restrict__ Kh, const bf16_t* __restrict__ Vh, bf16_t* __restrict__ mixin, int b, int kv, int frow0, char* lds, bool LIGHT) {
    const int tid = threadIdx.x, wid = tid >> 6, lane = tid & 63, r32 = lane & 31, hi = lane >> 5;
    const int seq = LPAD;
    bf16_t* V_lds = (bf16_t*)lds; bf16_t* K_lds = (bf16_t*)(lds + 2 * SHM_V);
    float* ws = (float*)(lds + 2 * SHM_V + 2 * SHM_K) + wid * 64; float* li_l = ws; float* al_l = ws + 32;
    float m_reg = -1e30f, l_reg = 0; f32x16 o[4] = {}; bf16x8 qr[8];
    const bf16_t* Qw = Qb + (long)(wid * QBLK + r32) * LDQ + hi * 8;
#pragma unroll
    for (int d0 = 0; d0 < 8; ++d0) qr[d0] = *reinterpret_cast<const bf16x8*>(Qw + d0 * 16);
    const int sr = tid >> 4, sc = (tid & 15) * 8, vst0 = v_st(sr, sc), vst1 = v_st(32 + sr, sc);
    const int vb0 = (int)(uintptr_t)V_lds + v_rd_base(lane);
    constexpr int SDEPTH = 1;
    struct { bf16x8 vs0, vs1, ks0, ks1; } sr_[SDEPTH];
#define SLOAD(i, k0) do { sr_[i].vs0 = *reinterpret_cast<const bf16x8*>(&Vh[(long)((k0) + sr) * LDK + sc]); sr_[i].vs1 = *reinterpret_cast<const bf16x8*>(&Vh[(long)((k0) + 32 + sr) * LDK + sc]); \
    sr_[i].ks0 = *reinterpret_cast<const bf16x8*>(&Kh[(long)((k0) + sr) * LDK + sc]); sr_[i].ks1 = *reinterpret_cast<const bf16x8*>(&Kh[(long)((k0) + 32 + sr) * LDK + sc]); } while (0)
#define SWRITE(bb, i) do { *(bf16x8*)((char*)V_lds + (bb) * SHM_V + vst0) = sr_[i].vs0;          \
    *(bf16x8*)((char*)V_lds + (bb) * SHM_V + vst1) = sr_[i].vs1; int kc = sc * 2;               \
    *(bf16x8*)((char*)K_lds + (bb) * SHM_K + KSWZ(sr, kc)) = sr_[i].ks0;                       \
    *(bf16x8*)((char*)K_lds + (bb) * SHM_K + KSWZ(32 + sr, kc)) = sr_[i].ks1; } while (0)
#define SWAIT() do { if constexpr (SDEPTH == 2) asm volatile("s_waitcnt vmcnt(4)" ::: "memory"); else asm volatile("s_waitcnt vmcnt(0)" ::: "memory"); } while (0)
#define RESC(a) do { if (__any((a) < 1.f)) { if (hi == 0) al_l[r32] = (a); asm volatile("s_waitcnt lgkmcnt(0)" ::: "memory"); \
    _Pragma("unroll") for (int d = 0; d < 4; ++d) _Pragma("unroll") for (int r = 0; r < 16; ++r) o[d][r] *= al_l[crow(r, hi)]; } } while (0)
#define MASK(P0, P1, T) do { if (((T) + 1) * KVBLK > NVALID) maskp(P0, P1, (T) * KVBLK, hi); } while (0)
    const int NT = seq / KVBLK;
    constexpr int SE = 0, SO = SDEPTH - 1;
    static_assert(SDEPTH == 1, "the staging-only path below mirrors the SDEPTH = 1 barrier sequence");
    if (LIGHT && wid >= 2) {
        SLOAD(SE, 0); asm volatile("s_waitcnt vmcnt(0)" ::: "memory"); SWRITE(0, SE); __syncthreads();
        SLOAD(SO, KVBLK); SWAIT(); SWRITE(1, SO); __syncthreads();
        for (int j = 1; j + 1 < NT; j += 2) {
            SLOAD(SO, (j + SDEPTH) * KVBLK);
            __syncthreads(); SWAIT(); SWRITE(0, SE);
            __syncthreads();
            SLOAD(SE, (j + 1 + SDEPTH) * KVBLK);
            __syncthreads(); SWAIT(); SWRITE(1, SO);
            __syncthreads();
        }
        __syncthreads();
    } else {
    f32x16 pA0, pA1, pB0, pB1; float mnA, mnB, alA, alB; bf16x8 pa0, pa1, pa2, pa3;
    SLOAD(SE, 0); asm volatile("s_waitcnt vmcnt(0)" ::: "memory"); SWRITE(0, SE); __syncthreads();
    qkt(pA0, pA1, K_lds, qr, r32, hi); partialSM(pA0, pA1, m_reg, mnA, alA);
    SLOAD(SO, KVBLK); if constexpr (SDEPTH == 2) { if (2 < NT) SLOAD(SE, 2 * KVBLK); }
    SWAIT(); SWRITE(1, SO); __syncthreads();
    for (int j = 1; j + 1 < NT; j += 2) {
        SBAR(); qkt(pB0, pB1, (bf16_t*)((char*)K_lds + SHM_K), qr, r32, hi); MASK(pB0, pB1, j);
        finishSM(pA0, pA1, alA, l_reg, pa0, pa1, pa2, pa3); SBAR();
        SLOAD(SO, (j + SDEPTH) * KVBLK); SBAR();
        pv_d0(o, vb0, pa0, pa1, pa2, pa3); partialSM(pB0, pB1, m_reg, mnB, alB);
        __syncthreads(); SWAIT(); SWRITE(0, SE);
        RESC(alB); __syncthreads();
        SBAR(); qkt(pA0, pA1, K_lds, qr, r32, hi); MASK(pA0, pA1, j + 1);
        finishSM(pB0, pB1, alB, l_reg, pa0, pa1, pa2, pa3); SBAR();
        if (SDEPTH == 1 || j + 3 < NT) SLOAD(SE, (j + 1 + SDEPTH) * KVBLK); SBAR();
        pv_d0(o, vb0 + (int)SHM_V, pa0, pa1, pa2, pa3); partialSM(pA0, pA1, m_reg, mnA, alA);
        __syncthreads(); SWAIT(); SWRITE(1, SO);
        RESC(alA); __syncthreads();
    }
    static_assert(NVALID <= (LPAD / KVBLK - 1) * KVBLK, "the last K/V tile must be padding only");
    finishSM(pA0, pA1, alA, l_reg, pa0, pa1, pa2, pa3); SBAR();
    pv_d0(o, vb0, pa0, pa1, pa2, pa3);
    __syncthreads();
    if (hi == 0) li_l[r32] = l_reg; asm volatile("s_waitcnt lgkmcnt(0)" ::: "memory");
#pragma unroll
    for (int r = 0; r < 16; ++r) { const int orow = crow(r, hi); const float rl = __builtin_amdgcn_rcpf(li_l[orow]);
        const int fr = frow0 + wid * QBLK + orow;
        if (fr < 3 * LSEQ) { const int gq = fr / LSEQ, l = fr - gq * LSEQ; bf16_t* dst = mixin + (size_t)row_of(b, l) * 2048 + (kv * 3 + gq) * 128 + r32;
#pragma unroll
            for (int d0 = 0; d0 < 4; ++d0) dst[d0 * 32] = f2bf(o[d0][r] * rl); } }
    }
    __syncthreads();
#undef SLOAD
#undef SWRITE
#undef SWAIT
#undef RESC
#undef MASK
}
}

DEVI void phase_odd_prep(const Params& p, int rep) {
    const int wid = threadIdx.x >> 6, lane = threadIdx.x & 63;
    if (rep == 0) { bf16_t* RQ = (bf16_t*)(p.ws + A_RQ); bf16_t* RK = (bf16_t*)(p.ws + A_RK); const float* rl = (const float*)(p.ws + T_ROPEL);
      const int t16 = lane & 15, sub = lane >> 4;
      for (int it0 = (blockIdx.x * 8 + wid) * 4; it0 < NTOK * 16; it0 += gridDim.x * 32) {
          const int it = it0 + sub; const int r = it >> 4, hs = it & 15; int b, l; bl_of(r, b, l);
          bf16_t* v = (hs < 8 ? RQ : RK) + (size_t)r * 1024 + (hs & 7) * 128 + t16 * 8;
          const u32x4 w = *(const u32x4*)v;
          const float x[8] = {bflo(w.x), bfhi(w.x), bflo(w.y), bfhi(w.y), bflo(w.z), bfhi(w.z), bflo(w.w), bfhi(w.w)};
          const float* cs = rl + ((size_t)l * 64 + 8 * (t16 & 7)) * 2; const bool lo = t16 < 8;
          float o[8];
#pragma unroll
          for (int e = 0; e < 8; ++e) { const float xp = __shfl_xor(x[e], 8); const float c = cs[2 * e], sn = cs[2 * e + 1]; o[e] = lo ? (x[e] * c - xp * sn) : (xp * sn + x[e] * c); }
          u32x4 ow; ow.x = cvtpk(o[0], o[1]); ow.y = cvtpk(o[2], o[3]); ow.z = cvtpk(o[4], o[5]); ow.w = cvtpk(o[6], o[7]);
          *(u32x4*)v = ow; } }
    { const bf16_t* MU = (const bf16_t*)(p.ws + A_MU); bf16_t* UC = (bf16_t*)(p.ws + A_UCMU); const float* cw = p.in[23]; const float* cb = p.in[24];
      for (int it = blockIdx.x * 512 + threadIdx.x; it < NTOK * 128; it += gridDim.x * 512) {
          const int r = it >> 7, c8 = (it & 127) * 8; int b, l; bl_of(r, b, l);
          float acc[8];
#pragma unroll
          for (int e = 0; e < 8; ++e) acc[e] = cb[c8 + e];
          u32x4 self = {0u, 0u, 0u, 0u};
#pragma unroll
          for (int w = 0; w < 5; ++w) { const int ll = l + w - 2; if (ll < 0 || ll >= LSEQ) continue;
              const u32x4 x = *(const u32x4*)(MU + (size_t)row_of(b, ll) * 1024 + c8); if (w == 2) self = x;
              const f32x4 w0 = *(const f32x4*)(cw + w * 1024 + c8), w1 = *(const f32x4*)(cw + w * 1024 + c8 + 4);
              acc[0] += bflo(x.x) * w0[0]; acc[1] += bfhi(x.x) * w0[1]; acc[2] += bflo(x.y) * w0[2]; acc[3] += bfhi(x.y) * w0[3];
              acc[4] += bflo(x.z) * w1[0]; acc[5] += bfhi(x.z) * w1[1]; acc[6] += bflo(x.w) * w1[2]; acc[7] += bfhi(x.w) * w1[3]; }
#pragma unroll
          for (int e = 0; e < 8; ++e) acc[e] = acc[e] * sigmoidf_(acc[e]);
          const int h = c8 >> 7, d = c8 & 127; bf16_t* dst = UC + (size_t)r * 2048 + h * 256 + d;
          u32x4 o; o.x = cvtpk(acc[0], acc[1]); o.y = cvtpk(acc[2], acc[3]); o.z = cvtpk(acc[4], acc[5]); o.w = cvtpk(acc[6], acc[7]);
          *(u32x4*)dst = o; *(u32x4*)(dst + 128) = self; } }
    { const float* G = (const float*)(p.ws + T_GATES); const float* gb = p.in[28];
      float* GA = (float*)(p.ws + T_GA); float* GPM = (float*)(p.ws + T_GPM); float* GBT = (float*)(p.ws + T_GBT);
      for (int it = blockIdx.x * 8 + wid; it < NB * 2 * 8 * 17; it += gridDim.x * 8) {
          const int n = it % 17, h = (it / 17) & 7, dir = (it / 136) & 1, b = it / 272;
          float lf[2], li[2];
#pragma unroll
          for (int e = 0; e < 2; ++e) { const int o = lane * 2 + e, pos = dir ? 127 - o : o, l = n * 128 + pos - 112;
              if (l >= 0) { const float* gr = G + (size_t)row_of(b, l) * 32; const float gi = gr[(2 * dir) * 8 + h] + gb[(2 * dir) * 8 + h], gf = gr[(2 * dir + 1) * 8 + h] + gb[(2 * dir + 1) * 8 + h];
                  li[e] = gi; lf[e] = fminf(gf, 0.f) - log1pf(__expf(-fabsf(gf))); }
              else { li[e] = -1e4f; lf[e] = 0.f; } }
          float s1 = lf[0] + lf[1], inc = s1;
#pragma unroll
          for (int o = 1; o < 64; o <<= 1) { const float t = __shfl_up(inc, o); if (lane >= o) inc += t; }
          const float bt1 = inc, bt0 = inc - lf[1];
          const float a0 = li[0] - bt0, a1 = li[1] - bt1;
          float mx = fmaxf(a0, a1);
#pragma unroll
          for (int o = 1; o < 64; o <<= 1) { const float t = __shfl_up(mx, o); if (lane >= o) mx = fmaxf(mx, t); }
          const float mprev = __shfl_up(mx, 1); const float pm0 = lane ? fmaxf(mprev, a0) : a0, pm1 = mx;
          const size_t base = (((size_t)b * 2 + dir) * 8 + h) * LPAD + n * 128;
          const int p0 = dir ? 127 - lane * 2 : lane * 2, p1 = dir ? 126 - lane * 2 : lane * 2 + 1;
          GA[base + p0] = a0; GA[base + p1] = a1; GPM[base + p0] = pm0; GPM[base + p1] = pm1; GBT[base + p0] = bt0; GBT[base + p1] = bt1; } }
}
DEVI void phase_combine(const Params& p) {
    const int wid = threadIdx.x >> 6, lane = threadIdx.x & 63, t16 = lane & 15, sub = lane >> 4;
    bf16_t* mix = (bf16_t*)(p.ws + A_MIXIN1);
    for (int it0 = (blockIdx.x * 8 + wid) * 4; it0 < NREAL * 16; it0 += gridDim.x * 32) {
        const int it = it0 + sub; const int r = it >> 4, hs = it & 15, h = hs & 7, ml = hs >> 3;
        const size_t off = (size_t)r * 1024 + h * 128 + t16 * 8;
        const u32x4 wf = *(const u32x4*)((const bf16_t*)(p.ws + (ml ? A_T2 : A_T0)) + off), wb = *(const u32x4*)((const bf16_t*)(p.ws + (ml ? A_T3 : A_T1)) + off);
        const u32x4 gw = *(const u32x4*)((const bf16_t*)(p.ws + (ml ? A_MO : A_RG)) + off);
        float x[8] = {bflo(wf.x) + bflo(wb.x), bfhi(wf.x) + bfhi(wb.x), bflo(wf.y) + bflo(wb.y), bfhi(wf.y) + bfhi(wb.y),
                      bflo(wf.z) + bflo(wb.z), bfhi(wf.z) + bfhi(wb.z), bflo(wf.w) + bflo(wb.w), bfhi(wf.w) + bfhi(wb.w)};
        const float g[8] = {bflo(gw.x), bfhi(gw.x), bflo(gw.y), bfhi(gw.y), bflo(gw.z), bfhi(gw.z), bflo(gw.w), bfhi(gw.w)};
        float sm = 0.f;
#pragma unroll
        for (int e = 0; e < 8; ++e) sm += x[e];
        sm += __shfl_xor(sm, 8); sm += __shfl_xor(sm, 4); sm += __shfl_xor(sm, 2); sm += __shfl_xor(sm, 1);
        const float mean = sm * (1.f / 128.f); float vs = 0.f;
#pragma unroll
        for (int e = 0; e < 8; ++e) { x[e] -= mean; vs += x[e] * x[e]; }
        vs += __shfl_xor(vs, 8); vs += __shfl_xor(vs, 4); vs += __shfl_xor(vs, 2); vs += __shfl_xor(vs, 1);
        const float rs = rsqrtf(vs * (1.f / 128.f) + EPS);
        const float* gn = (ml ? p.in[29] : p.in[22]) + h * 128 + t16 * 8; const f32x4 n0 = *(const f32x4*)gn, n1 = *(const f32x4*)(gn + 4);
        float o[8];
#pragma unroll
        for (int e = 0; e < 8; ++e) { const float sg = sigmoidf_(g[e]); const float tt = ml ? sg : g[e] * sg; o[e] = x[e] * rs * (e < 4 ? n0[e] : n1[e - 4]) * tt; }
        u32x4 ow; ow.x = cvtpk(o[0], o[1]); ow.y = cvtpk(o[2], o[3]); ow.z = cvtpk(o[4], o[5]); ow.w = cvtpk(o[6], o[7]);
        *(u32x4*)(mix + (size_t)r * 2048 + ml * 1024 + h * 128 + t16 * 8) = ow;
    }
}

namespace ch {
DEVI unsigned offb(unsigned row, unsigned c16) { return 256u * row + 16u * (c16 ^ (((row & 3u) << 2) | ((row >> 2) & 3u))); }
DEVI s16x4 trr(unsigned addr) { s16x4 r; asm volatile("ds_read_b64_tr_b16 %0, %1" : "=&v"(r) : "v"(addr) : "memory"); return r; }
#define LWAIT() do { asm volatile("s_waitcnt lgkmcnt(0)" ::: "memory"); __builtin_amdgcn_sched_barrier(0); } while (0)
#define PK8(L, H) (bf16x8){L[0], L[1], L[2], L[3], H[0], H[1], H[2], H[3]}
DEVI int crow(int r, int hi) { return (r & 3) + 8 * (r >> 2) + 4 * hi; }
struct TrL { unsigned hi, blk, q, p; DEVI void init(int lane) { hi = lane >> 5; blk = (lane >> 4) & 1; q = (lane & 15) >> 2; p = lane & 3; } };
DEVI unsigned tra_nat(const TrL& t, unsigned img, int k0, int c, int tt) { return img + offb(k0 + 8 * t.hi + 4 * tt + t.q, 4 * c + 2 * t.blk + (t.p >> 1)) + 8 * (t.p & 1); }
DEVI unsigned tra_perm(const TrL& t, unsigned img, int k0, int c, int tt) { return img + offb(k0 + 8 * tt + 4 * t.hi + t.q, 4 * c + 2 * t.blk + (t.p >> 1)) + 8 * (t.p & 1); }
DEVI u32x4 scale8(u32x4 w, float s) { u32x4 o; o.x = cvtpk(bflo(w.x) * s, bfhi(w.x) * s); o.y = cvtpk(bflo(w.y) * s, bfhi(w.y) * s); o.z = cvtpk(bflo(w.z) * s, bfhi(w.z) * s); o.w = cvtpk(bflo(w.w) * s, bfhi(w.w) * s); return o; }

template <bool SC, int UNR, class F> DEVI void stage_tile(char* img, const bf16_t* base, int ld, int b, int n, const F& rs) {
#pragma unroll UNR
    for (int it = 0; it < 4; ++it) { const int idx = threadIdx.x + 512 * it, row = idx >> 4, c16 = idx & 15, l = n * 128 + row - 112;
        u32x4 w = {0u, 0u, 0u, 0u};
        if (l >= 0) { w = *(const u32x4*)(base + (size_t)row_of(b, l) * ld + c16 * 8); if (SC) w = scale8(w, rs(row)); }
        *(u32x4*)(img + offb(row, c16)) = w; }
}
template <bool SC> DEVI void load_q(bf16x8 (&qf)[8], const bf16_t* base, int ld, int b, int lq, int hi, float s) {
#pragma unroll
    for (int ks = 0; ks < 8; ++ks) { u32x4 w = {0u, 0u, 0u, 0u};
        if (lq >= 0) { w = *(const u32x4*)(base + (size_t)row_of(b, lq) * ld + ks * 16 + hi * 8); if (SC) w = scale8(w, s); }
        qf[ks] = *reinterpret_cast<bf16x8*>(&w); }
}
DEVI void scoresT(f32x16 (&p)[4], const char* Kimg, const bf16x8 (&qf)[8], int r32, int hi) {
#pragma unroll
    for (int kt = 0; kt < 4; ++kt) { p[kt] = f32x16{};
#pragma unroll
        for (int ks = 0; ks < 8; ++ks) { const bf16x8 a = *(const bf16x8*)(Kimg + offb(32 * kt + r32, 2 * ks + hi)); p[kt] = __builtin_amdgcn_mfma_f32_32x32x16_f16(H8(a), H8(qf[ks]), p[kt], 0, 0, 0); } }
}
DEVI f32x16 scoresT1(int kt, const char* Kimg, const bf16x8 (&qf)[8], int r32, int hi) {
    f32x16 p = {};
#pragma unroll
    for (int ks = 0; ks < 8; ++ks) { const bf16x8 a = *(const bf16x8*)(Kimg + offb(32 * kt + r32, 2 * ks + hi)); p = __builtin_amdgcn_mfma_f32_32x32x16_f16(H8(a), H8(qf[ks]), p, 0, 0, 0); }
    return p;
}
DEVI void packP1(bf16x8& p0, bf16x8& p1, const f32x16& p) {
    u32x4 w; w.x = cvtpk(p[0], p[1]); w.y = cvtpk(p[2], p[3]); w.z = cvtpk(p[4], p[5]); w.w = cvtpk(p[6], p[7]); p0 = *reinterpret_cast<bf16x8*>(&w);
    u32x4 v; v.x = cvtpk(p[8], p[9]); v.y = cvtpk(p[10], p[11]); v.z = cvtpk(p[12], p[13]); v.w = cvtpk(p[14], p[15]); p1 = *reinterpret_cast<bf16x8*>(&v);
}
DEVI void packP(bf16x8 (&pb)[8], const f32x16 (&p)[4]) {
#pragma unroll
    for (int kt = 0; kt < 4; ++kt)
#pragma unroll
        for (int ss = 0; ss < 2; ++ss) { u32x4 w; w.x = cvtpk(p[kt][8 * ss], p[kt][8 * ss + 1]); w.y = cvtpk(p[kt][8 * ss + 2], p[kt][8 * ss + 3]);
            w.z = cvtpk(p[kt][8 * ss + 4], p[kt][8 * ss + 5]); w.w = cvtpk(p[kt][8 * ss + 6], p[kt][8 * ss + 7]); pb[kt * 2 + ss] = *reinterpret_cast<bf16x8*>(&w); }
}
DEVI void inter_acc(f32x16& o, const char* Rt, int c, const bf16x8 (&qf)[8], int r32, int hi) {
#pragma unroll
    for (int ks = 0; ks < 8; ++ks) { const bf16x8 a = *(const bf16x8*)(Rt + offb(32 * c + r32, 2 * ks + hi)); o = __builtin_amdgcn_mfma_f32_32x32x16_f16(H8(a), H8(qf[ks]), o, 0, 0, 0); }
}
DEVI void intra_acc(f32x16& o, unsigned Vimg, int c, const bf16x8 (&pb)[8], const TrL& t) {
#pragma unroll
    for (int half = 0; half < 2; ++half) {
        s16x4 lo[4], hh[4];
#pragma unroll
        for (int k = 0; k < 4; ++k) { const int kk = half * 4 + k; lo[k] = trr(tra_perm(t, Vimg, 16 * kk, c, 0)); hh[k] = trr(tra_perm(t, Vimg, 16 * kk, c, 1)); }
        LWAIT();
#pragma unroll
        for (int k = 0; k < 4; ++k) o = __builtin_amdgcn_mfma_f32_32x32x16_f16(H8(PK8(lo[k], hh[k])), H8(pb[half * 4 + k]), o, 0, 0, 0);
    }
}
DEVI void state_acc(f32x16& acc, unsigned Kimg, unsigned Vimg, int qb, int c, const TrL& t) {
#pragma unroll
    for (int half = 0; half < 2; ++half) {
        s16x4 al[4], ah[4], bl[4], bh[4];
#pragma unroll
        for (int k = 0; k < 4; ++k) { const int ks = half * 4 + k; al[k] = trr(tra_nat(t, Kimg, 16 * ks, qb, 0)); ah[k] = trr(tra_nat(t, Kimg, 16 * ks, qb, 1));
            bl[k] = trr(tra_nat(t, Vimg, 16 * ks, c, 0)); bh[k] = trr(tra_nat(t, Vimg, 16 * ks, c, 1)); }
        LWAIT();
#pragma unroll
        for (int k = 0; k < 4; ++k) acc = __builtin_amdgcn_mfma_f32_32x32x16_f16(H8(PK8(al[k], ah[k])), H8(PK8(bl[k], bh[k])), acc, 0, 0, 0);
    }
}
DEVI void state_acc_w(f32x16& acc, unsigned Kimg, unsigned Vimg, const bf16_t* wtab, int qb, int c, const TrL& t) {
#pragma unroll
    for (int half = 0; half < 2; ++half) {
        s16x4 al[4], ah[4], bl[4], bh[4];
#pragma unroll
        for (int k = 0; k < 4; ++k) { const int ks = half * 4 + k; al[k] = trr(tra_nat(t, Kimg, 16 * ks, qb, 0)); ah[k] = trr(tra_nat(t, Kimg, 16 * ks, qb, 1));
            bl[k] = trr(tra_nat(t, Vimg, 16 * ks, c, 0)); bh[k] = trr(tra_nat(t, Vimg, 16 * ks, c, 1)); }
        LWAIT();
#pragma unroll
        for (int k = 0; k < 4; ++k) { const f16x8 wf = *(const f16x8*)(wtab + 16 * (half * 4 + k) + 8 * t.hi);
            const f16x8 bv = H8(PK8(bl[k], bh[k])) * wf;
            acc = __builtin_amdgcn_mfma_f32_32x32x16_f16(H8(PK8(al[k], ah[k])), bv, acc, 0, 0, 0); }
    }
}
DEVI void write_Rt(char* Rt, const f32x16& acc, int qb, int c, int r32, int hi) {
#pragma unroll
    for (int rg = 0; rg < 4; ++rg) { u32x2 w; w.x = cvtpk(acc[4 * rg], acc[4 * rg + 1]); w.y = cvtpk(acc[4 * rg + 2], acc[4 * rg + 3]);
        *(u32x2*)(Rt + offb(32 * c + r32, 4 * qb + rg) + 8 * hi) = w; }
}
DEVI void store_o(bf16_t* dst  , const f32x16& o, int c, int hi, float s) {
#pragma unroll
    for (int rg = 0; rg < 4; ++rg) { u32x2 w; w.x = cvtpk(o[4 * rg] * s, o[4 * rg + 1] * s); w.y = cvtpk(o[4 * rg + 2] * s, o[4 * rg + 3] * s);
        *(u32x2*)(dst + 32 * c + 8 * rg + 4 * hi) = w; }
}

DEVI void retention_chain(const Params& p, int b, int h, int dir, char* lds) {
    int tid = threadIdx.x; asm volatile("" : "+v"(tid)); const int wid = __builtin_amdgcn_readfirstlane(tid >> 6), lane = tid & 63, qb = wid & 3, eh = wid >> 2; int r32 = lane & 31, hi = lane >> 5;
    TrL t; t.init(lane);
    char* Kimg = lds; char* Vimg = lds + 32768; char* Rt = lds + 65536;
    const unsigned Ka = (unsigned)(uintptr_t)Kimg, Va = (unsigned)(uintptr_t)Vimg;
    const bf16_t* RQ = (const bf16_t*)(p.ws + A_RQ) + h * 128; const bf16_t* RK = (const bf16_t*)(p.ws + A_RK) + h * 128; const bf16_t* RV = (const bf16_t*)(p.ws + A_RV) + h * 128;
    bf16_t* T = (bf16_t*)(p.ws + (dir ? A_T1 : A_T0)) + h * 128;
    const float lg2 = -fabsf(p.in[21][dir * 8 + h]) * 1.4426950408889634f;
    const float g128 = __builtin_amdgcn_exp2f(128.f * lg2);
    for (int i = tid; i < 2048; i += 512) *(u32x4*)(Rt + i * 16) = (u32x4){0u, 0u, 0u, 0u};
    f32x16 racc[2] = {};
    int q = 32 * qb + r32;
    const float qs = 0.088388347648318440f * __builtin_amdgcn_exp2f(lg2 * (dir ? -(float)q : (float)(q - 127)));
    __syncthreads();
#pragma unroll 1
    for (int st = 0; st < 17; ++st) { const int n = dir ? 16 - st : st;
        asm volatile("" : "+v"(r32), "+v"(hi), "+v"(t.hi), "+v"(t.blk), "+v"(t.q), "+v"(t.p), "+v"(q));
        stage_tile<true, 4>(Kimg, RK, 1024, b, n, [&](int row) { return __builtin_amdgcn_exp2f(lg2 * (dir ? (float)row : (float)(127 - row))); });
        stage_tile<false, 4>(Vimg, RV, 1024, b, n, [&](int) { return 1.f; });
        const int lq = n * 128 + q - 112;
        bf16x8 qf[8]; load_q<true>(qf, RQ, 1024, b, lq, hi, qs);
        __syncthreads();
        bf16x8 pb[8];
#pragma unroll
        for (int kt = 0; kt < 4; ++kt) { f32x16 pt = scoresT1(kt, Kimg, qf, r32, hi);
#pragma unroll
            for (int r = 0; r < 16; ++r) { const int s = 32 * kt + crow(r, hi); const bool keep = dir ? (s > q) : (s <= q); if (!keep) pt[r] = 0.f; }
            packP1(pb[2 * kt], pb[2 * kt + 1], pt); }
#pragma unroll
        for (int x = 0; x < 2; ++x) { const int c = 2 * eh + x; f32x16 o = {};
            inter_acc(o, Rt, c, qf, r32, hi); intra_acc(o, Va, c, pb, t);
            if (lq >= 0) store_o(T + (size_t)row_of(b, lq) * 1024, o, c, hi, 1.f); }
        __syncthreads();
#pragma unroll
        for (int x = 0; x < 2; ++x) { const int c = 2 * eh + x; state_acc(racc[x], Ka, Va, qb, c, t);
#pragma unroll
            for (int r = 0; r < 16; ++r) racc[x][r] *= g128;
            write_Rt(Rt, racc[x], qb, c, r32, hi); }
        __syncthreads();
    }
}

#ifndef MLU
#define MLU 4
#endif
DEVI void mlstm_chain(const Params& p, int b, int h, int dir, char* lds) {
    int tid = threadIdx.x; asm volatile("" : "+v"(tid)); const int wid = __builtin_amdgcn_readfirstlane(tid >> 6), lane = tid & 63, qb = wid & 3, eh = wid >> 2; int r32 = lane & 31, hi = lane >> 5;
    TrL t; t.init(lane);
    char* Kimg = lds; char* Vimg = lds + 32768; char* Ct = lds + 65536; char* Khat = lds + 98304; char* Nimg = lds + 131072;
    float* ta = (float*)(lds + 139264); float* tpm = ta + 128; float* tbt = ta + 256; float* tn = ta + 384; bf16_t* wtab = (bf16_t*)(lds + 98304);
    const unsigned Va = (unsigned)(uintptr_t)Vimg, Ka = (unsigned)(uintptr_t)Kimg;
    const bf16_t* MQ = (const bf16_t*)(p.ws + A_MQKV) + h * 384; const bf16_t* MK = MQ + 128; const bf16_t* MV = MQ + 256;
    bf16_t* T = (bf16_t*)(p.ws + (dir ? A_T3 : A_T2)) + h * 128;
    const size_t gbase = (((size_t)b * 2 + dir) * 8 + h) * LPAD;
    const float* GA = (const float*)(p.ws + T_GA) + gbase; const float* GPM = (const float*)(p.ws + T_GPM) + gbase; const float* GBT = (const float*)(p.ws + T_GBT) + gbase;
    for (int i = tid; i < 2048 + 512; i += 512) *(u32x4*)(Ct + (i < 2048 ? i * 16 : 65536 + (i - 2048) * 16)) = (u32x4){0u, 0u, 0u, 0u};
    f32x16 cacc[2] = {};
    if (tid < 128) tn[tid] = 0.f;
    float m_prev = 0.f;
    int q = 32 * qb + r32;
    __syncthreads();
#pragma unroll 1
    for (int st = 0; st < 17; ++st) { const int n = dir ? 16 - st : st;
        asm volatile("" : "+v"(r32), "+v"(hi), "+v"(t.hi), "+v"(t.blk), "+v"(t.q), "+v"(t.p), "+v"(q));
        const int pe = n * 128 + (dir ? 0 : 127);
        const float amax = GPM[pe], btT = GBT[pe];
        const float m_loc = amax + btT, m_new = fmaxf(btT + m_prev, m_loc), f_prev = __expf(btT + m_prev - m_new), f_loc = __expf(m_loc - m_new);
        stage_tile<false, MLU>(Kimg, MK, 3072, b, n, [&](int) { return 1.f; });
        stage_tile<false, MLU>(Vimg, MV, 3072, b, n, [&](int) { return 1.f; });
        if (tid < 128) { const float av = GA[n * 128 + tid]; ta[tid] = av; tpm[tid] = GPM[n * 128 + tid]; tbt[tid] = GBT[n * 128 + tid]; wtab[tid] = f2bf(__expf(av - amax) * f_loc); }
        const int lq = n * 128 + q - 112;
        bf16x8 qf[8]; load_q<false>(qf, MQ, 3072, b, lq, hi, 1.f);
        __syncthreads();
        const float Mq = fmaxf(m_prev, tpm[q]), w_inter = __expf(m_prev - Mq), m_t = tbt[q] + Mq;
        f32x16 qn = {};
#pragma unroll
        for (int ks = 0; ks < 8; ++ks) { const bf16x8 a = *(const bf16x8*)(Nimg + offb(r32, 2 * ks + hi)); qn = __builtin_amdgcn_mfma_f32_32x32x16_f16(H8(a), H8(qf[ks]), qn, 0, 0, 0); }
        float qns = 0.f;
#pragma unroll
        for (int r = 0; r < 16; ++r) qns += qn[r];
        { auto rr = __builtin_amdgcn_permlane32_swap(__float_as_uint(qns), __float_as_uint(qns), false, false); qns = __uint_as_float(rr[0]) + __uint_as_float(rr[1]); }
        float ds = 0.f; bf16x8 pb[8];
#pragma unroll
        for (int kt = 0; kt < 4; ++kt) { f32x16 pt = scoresT1(kt, Kimg, qf, r32, hi);
#pragma unroll
            for (int rg = 0; rg < 4; ++rg) { const int s0 = 32 * kt + 8 * rg + 4 * hi; const f32x4 av = *(const f32x4*)(ta + s0);
#pragma unroll
                for (int e = 0; e < 4; ++e) { const int s = s0 + e; const bool keep = dir ? (s >= q) : (s <= q);
                    const float w = keep ? __expf(av[e] - Mq) : 0.f; const float v = pt[4 * rg + e] * w; pt[4 * rg + e] = v; ds += v; } }
            packP1(pb[2 * kt], pb[2 * kt + 1], pt); }
        { auto rr = __builtin_amdgcn_permlane32_swap(__float_as_uint(ds), __float_as_uint(ds), false, false); ds = __uint_as_float(rr[0]) + __uint_as_float(rr[1]); }
        const float den = ds + w_inter * qns;
        const float inv = 1.f / fmaxf(fabsf(den), __expf(-m_t));
#pragma unroll
        for (int x = 0; x < 2; ++x) { const int c = 2 * eh + x; f32x16 o = {};
            inter_acc(o, Ct, c, qf, r32, hi);
#pragma unroll
            for (int r = 0; r < 16; ++r) o[r] *= w_inter;
            intra_acc(o, Va, c, pb, t);
            if (lq >= 0) store_o(T + (size_t)row_of(b, lq) * 1024, o, c, hi, inv); }
        __syncthreads();
#pragma unroll
        for (int x = 0; x < 2; ++x) { const int c = 2 * eh + x;
#pragma unroll
            for (int r = 0; r < 16; ++r) cacc[x][r] *= f_prev;
            state_acc_w(cacc[x], Ka, Va, wtab, qb, c, t); write_Rt(Ct, cacc[x], qb, c, r32, hi); }
        if (eh == 0) {
            f32x16 nacc = {};
#pragma unroll
            for (int half = 0; half < 2; ++half) { s16x4 al[4], ah[4];
#pragma unroll
                for (int k = 0; k < 4; ++k) { const int ks = half * 4 + k; al[k] = trr(tra_nat(t, Ka, 16 * ks, qb, 0)); ah[k] = trr(tra_nat(t, Ka, 16 * ks, qb, 1)); }
                LWAIT();
#pragma unroll
                for (int k = 0; k < 4; ++k) { const f16x8 wf = *(const f16x8*)(wtab + 16 * (half * 4 + k) + 8 * t.hi); nacc = __builtin_amdgcn_mfma_f32_32x32x16_f16(H8(PK8(al[k], ah[k])), wf, nacc, 0, 0, 0); } }
            if (r32 == 0) {
#pragma unroll
                for (int rg = 0; rg < 4; ++rg) { float* np = tn + 32 * qb + 8 * rg + 4 * hi; f32x4 nv = *(f32x4*)np;
#pragma unroll
                    for (int e = 0; e < 4; ++e) nv[e] = nv[e] * f_prev + nacc[4 * rg + e];
                    *(f32x4*)np = nv; u32x2 w; w.x = cvtpk(nv[0], nv[1]); w.y = cvtpk(nv[2], nv[3]);
                    *(u32x2*)(Nimg + offb(0, 4 * qb + rg) + 8 * hi) = w; } }
        }
        m_prev = m_new;
        __syncthreads();
    }
}
}

#define XB_TMO      128
#define XB_XCNT(j)  (256  + 64 * (j))
#define XB_XSUB(j)  (1280 + 64 * (j))
#define XB_XGEN(j)  (2304 + 64 * (j))
#define XB_TOP      3328
#define XB_TOPGEN   3392
#define XCD_BAR_WORDS 3456
#define XB_SPIN_CAP (1u << 18)
DEVI unsigned xb_ld(unsigned* p)              { return __hip_atomic_load(p, __ATOMIC_RELAXED, __HIP_MEMORY_SCOPE_AGENT); }
DEVI unsigned xb_add(unsigned* p, unsigned v) { return __hip_atomic_fetch_add(p, v, __ATOMIC_RELAXED, __HIP_MEMORY_SCOPE_AGENT); }
DEVI unsigned xb_xcc_id() { return (unsigned)__builtin_amdgcn_s_getreg((3 << 11) | 20) & 0xFu; }
#define XB_SPIN(cond, bar) do { unsigned _sp = 0; while (cond) { __builtin_amdgcn_s_sleep(1); \
    if ((++_sp & 255u) == 0u) { if (xb_ld(&(bar)[XB_TMO])) break; if (_sp > XB_SPIN_CAP) { atomicAdd(&(bar)[XB_TMO], 1u); break; } } } } while (0)
struct XcdBarrier { unsigned* bar; unsigned x; volatile LAS unsigned* st; };
DEVI XcdBarrier xcd_barrier_post(unsigned* bar, volatile LAS unsigned* st) {
    XcdBarrier b; b.bar = bar; b.x = xb_xcc_id(); b.st = st;
    if (threadIdx.x == 0) (void)xb_add(&bar[XB_XCNT(b.x)], 1u);
    return b;
}
DEVI void xcd_barrier_complete(unsigned* bar, unsigned x, unsigned& nloc, unsigned& nx) {
    const unsigned G = gridDim.x * gridDim.y * gridDim.z;
    unsigned sum, cnt, mine, sp = 0u;
    for (;;) {
        sum = 0u; cnt = 0u; mine = 0u;
#pragma unroll
        for (unsigned j = 0; j < 16; ++j) { const unsigned c = xb_ld(&bar[XB_XCNT(j)]); sum += c; cnt += (c > 0u) ? 1u : 0u; mine = (j == x) ? c : mine; }
        if (sum == G) break;
        __builtin_amdgcn_s_sleep(1);
        if ((++sp & 255u) == 0u) { if (xb_ld(&bar[XB_TMO])) break; if (sp > XB_SPIN_CAP) { atomicAdd(&bar[XB_TMO], 1u); break; } }
    }
    nloc = mine > 0u ? mine : 1u; nx = cnt > 0u ? cnt : 1u;
}
DEVI void xcd_barrier(const XcdBarrier& b) {
    asm volatile("s_waitcnt vmcnt(0)" ::: "memory");
    __syncthreads();
    if (threadIdx.x == 0) {
        unsigned* bar = b.bar;
        __builtin_amdgcn_s_waitcnt(0);
        unsigned nloc = b.st[0], nx = b.st[1];
        if (nloc == 0u) { xcd_barrier_complete(bar, b.x, nloc, nx); b.st[0] = nloc; b.st[1] = nx; }
        const unsigned old = xb_add(&bar[XB_XSUB(b.x)], 1u);
        const unsigned gen = old / nloc;
        if (old + 1u == (gen + 1u) * nloc) {
            __builtin_amdgcn_fence(__ATOMIC_RELEASE, "agent");
            asm volatile("s_waitcnt vmcnt(0)" ::: "memory");
            const unsigned og = xb_add(&bar[XB_TOP], 1u);
            const unsigned tg = og / nx;
            if (og + 1u == (tg + 1u) * nx) xb_add(&bar[XB_TOPGEN], 1u);
            else XB_SPIN(xb_ld(&bar[XB_TOPGEN]) == tg, bar);
            __builtin_amdgcn_fence(__ATOMIC_ACQUIRE, "agent");
            xb_add(&bar[XB_XGEN(b.x)], 1u);
            asm volatile("s_waitcnt vmcnt(0)" ::: "memory");
        } else {
            XB_SPIN(xb_ld(&bar[XB_XGEN(b.x)]) == gen, bar);
            __builtin_amdgcn_fence(__ATOMIC_ACQUIRE, "agent");
            asm volatile("s_waitcnt vmcnt(0)" ::: "memory");
        }
    }
    __syncthreads();
}

constexpr int LDS_BYTES = 141312 + 16;
constexpr int NPHASE = 21;
#ifndef PH_MASK
#define PH_MASK 0xFFFFFFFFu
#endif
#define PHON(n) (((PH_MASK) >> (n)) & 1u)
#ifndef REP_MASK
#define REP_MASK 0u
#endif

DEVI void mlw_fill(const Params& p) {
    bf16_t* W = (bf16_t*)(p.ws + W_MLW);
    for (int i = blockIdx.x * 512 + threadIdx.x; i < 8 * 512 * 256; i += gridDim.x * 512) {
        const int k = i & 255, n = (i >> 8) & 511, h = i >> 17; float v = 0.f;
        if (n < 128) { if (k < 128) v = p.in[25][((size_t)h * 128 + k) * 128 + n]; }
        else if (n < 256) { if (k < 128) v = p.in[26][((size_t)h * 128 + k) * 128 + (n - 128)] * 0.088388347648318440f; }
        else if (n < 384) { if (k >= 128) v = p.in[27][((size_t)h * 128 + (k - 128)) * 128 + (n - 256)]; }
        W[i] = f2bf(v);
    }
}

template <int PH> DEVI void phase_body(const Params& p, LAS unsigned char* lds, unsigned char* shm, int rep = 0) {
    unsigned char* ws = p.ws;
    bf16_t* X = (bf16_t*)(ws + A_X);
    const int G = gridDim.x;
    switch (PH) {
        case 0: if constexpr (PHON(0) && PH == 0) {
            phase_tables(p);
            tcvt_job(p.in[5], 2048, 3072, (bf16_t*)(ws + W_WINT), 2048, (float*)shm);
            tcvt_job(p.in[6], 2048, 2048, (bf16_t*)(ws + W_WOUT0), 2048, (float*)shm);
            tcvt_job(p.in[17], 512, 512, (bf16_t*)(ws + W_GLUT), 512, (float*)shm);
            phase_init_h(p, p.in[2]);
        } break;
        case 1: if constexpr (PHON(1) && PH == 1) {
            phase_s5_build(p);
            __syncthreads();
            pg8::Gemm g{X, (const bf16_t*)(ws + W_WINT), 2048, 2048, 2048, 65, 12, 1, 0, 0};
            pg8::EpiWin0 E{(bf16_t*)(ws + A_PROJ0), (bf16_t*)(ws + A_A2)};
            pg8::gemm_phase(lds, g, E);
        } break;
        case 2: if constexpr (PHON(2) && PH == 2) {
            phase_s5_build2(p);
            pg8::Gemm g{(const bf16_t*)(ws + A_A2), (const bf16_t*)(ws + W_S5E), 512, 256, 256, 5, 1, 32, (size_t)1280 * 512, (size_t)256 * 256};
            pg8::EpiF32 E{(float*)(ws + A_S), 256, (size_t)1280 * 256};
            pg8::gemm_phase(lds, g, E);
            __syncthreads();
            phase_qk(p);
        } break;
        case 3: if constexpr (PHON(3) && PH == 3) {
            phase_s5_scan(p);
            __syncthreads();
#ifndef ATT_REP
#define ATT_REP 1
#endif
            int natt = NB * 4 * 25 * ATT_REP; if (ATT_REP > 1) asm volatile("" : "+s"(natt));
            for (int it0 = blockIdx.x; it0 < natt; it0 += G) {
                const int it = it0 % (NB * 4 * 25);
                const bool light = it >= 768; const int bk = light ? it - 768 : it / 24, qb = light ? 24 : it % 24, b = bk >> 2, kv = bk & 3;
                const bf16_t* qp = (const bf16_t*)(ws + A_QB) + ((size_t)bk * QROWS + qb * 256) * 128; const bf16_t* kp = (const bf16_t*)(ws + A_KB) + (size_t)bk * LPAD * 128; const bf16_t* vp = (const bf16_t*)(ws + A_VB) + (size_t)bk * LPAD * 128;
                att::attn_body(qp, kp, vp, (bf16_t*)(ws + A_MIXIN0), b, kv, qb * 256, (char*)shm, light);
            }
            if (rep == 0) {
                tcvt_job(p.in[3], 2048, 8192, (bf16_t*)(ws + W_W1T), 2048, (float*)shm);
                tcvt_job(p.in[4], 8192, 2048, (bf16_t*)(ws + W_W2T), 8192, (float*)shm);
            }
        } break;
        case 4: if constexpr (PHON(4) && PH == 4) {
            pg8::Gemm g{(const bf16_t*)(ws + A_A2), (const bf16_t*)(ws + W_S5WY), 512, 512, 512, 5, 1, 32, (size_t)1280 * 512, (size_t)256 * 512};
            pg8::EpiS5Y E{(bf16_t*)(ws + A_YS)};
            pg8::gemm_phase(lds, g, E);
        } break;
        case 5: if constexpr (PHON(5) && PH == 5) {
            pg8::Gemm g{(const bf16_t*)(ws + A_YS), (const bf16_t*)(ws + W_GLUT), 512, 512, 512, 65, 2, 1, 0, 0};
            pg8::EpiGlu E{(const bf16_t*)(ws + A_YS), p.in[18], (bf16_t*)(ws + A_MIXIN0)};
            pg8::gemm_phase(lds, g, E);
        } break;
        case 6: if constexpr (PHON(6) && PH == 6) {
            pg8::Gemm g{(const bf16_t*)(ws + A_MIXIN0), (const bf16_t*)(ws + W_WOUT0), 2048, 2048, 2048, 64, 8, 1, 0, 0};
            pg8::EpiBf16<0> E{X, 2048};
            pg8::gemm_phase(lds, g, E);
            pg8::Gemm gt{(const bf16_t*)(ws + A_MIXIN0) + (size_t)NREAL * 2048, (const bf16_t*)(ws + W_WOUT0), 2048, 2048, 256, 1, 8, 8, 256, 256};
            pg8::EpiPart Et{(float*)(ws + A_PT)};
            pg8::gemm_phase(lds, gt, Et);
        } break;
        case 7: if constexpr (PHON(7) && PH == 7) { phase_norm<0>(p, NTOK, p.in[2] + 1 * DM, p.in[2] + 2 * DM, (const float*)(p.ws + A_PT), 8, rep ? 0.f : 1.f, rep ? nullptr : p.in[0]); } break;
        case 8: if constexpr (PHON(8) && PH == 8) {
            pg8::Gemm g{X, (const bf16_t*)(ws + W_W1T), 2048, 2048, 2048, 65, 32, 1, 0, 0};
            pg8::EpiBf16<1> E{(bf16_t*)(ws + A_MID), 8192};
            pg8::gemm_phase(lds, g, E);
        } break;
        case 9: if constexpr (PHON(9) && PH == 9) {
            pg8::Gemm g{(const bf16_t*)(ws + A_MID), (const bf16_t*)(ws + W_W2T), 8192, 8192, 8192, 64, 8, 1, 0, 0};
            pg8::EpiBf16<0> E{X, 2048};
            pg8::gemm_phase(lds, g, E);
            pg8::Gemm gt{(const bf16_t*)(ws + A_MID) + (size_t)NREAL * 8192, (const bf16_t*)(ws + W_W2T), 8192, 8192, 512, 1, 8, 16, 512, 512};
            pg8::EpiPart Et{(float*)(ws + A_PT)};
            pg8::gemm_phase(lds, gt, Et);
        } break;
        case 10: if constexpr (PHON(10) && PH == 10) {
            phase_norm<0>(p, NTOK, p.in[2] + 3 * DM, p.in[2] + 4 * DM, (const float*)(p.ws + A_PT), 16, rep ? 0.f : 1.f);
            tcvt_job(p.in[19], 2048, 6176, (bf16_t*)(ws + W_WINT), 2048, (float*)shm);
            tcvt_job(p.in[20], 2048, 2048, (bf16_t*)(ws + W_WOUT1), 2048, (float*)shm);
            for (int i = blockIdx.x * 512 + threadIdx.x; i < 224 * 256; i += G * 512) *(u32x4*)(ws + W_WINT + (size_t)6176 * 4096 + (size_t)i * 16) = (u32x4){0u, 0u, 0u, 0u};
            mlw_fill(p);
        } break;
        case 11: if constexpr (PHON(11) && PH == 11) {
            pg8::Gemm g{X, (const bf16_t*)(ws + W_WINT), 2048, 2048, 2048, 65, 25, 1, 0, 0};
            pg8::EpiWin1 E{(bf16_t*)(ws + A_RQ), (float*)(ws + T_GATES)};
            pg8::gemm_phase(lds, g, E);
            if (blockIdx.x >= 89 && rep == 0) {
                tcvt_job(p.in[3] + (size_t)2048 * 8192, 2048, 8192, (bf16_t*)(ws + W_W1T), 2048, (float*)shm, (int)blockIdx.x - 89, G - 89);
                tcvt_job(p.in[4] + (size_t)2048 * 8192, 8192, 2048, (bf16_t*)(ws + W_W2T), 8192, (float*)shm, (int)blockIdx.x - 89, G - 89);
            }
        } break;
        case 12: if constexpr (PHON(12) && PH == 12) { phase_odd_prep(p, rep); } break;
        case 13: if constexpr (PHON(13) && PH == 13) {
            pg8::Gemm g{(const bf16_t*)(ws + A_UCMU), (const bf16_t*)(ws + W_MLW), 2048, 256, 256, 65, 2, 8, 256, (size_t)512 * 256};
            pg8::EpiMqkv E{(bf16_t*)(ws + A_MQKV)};
            pg8::gemm_phase(lds, g, E);
        } break;
        case 14: if constexpr (PHON(14) && PH == 14) {
            for (int it = blockIdx.x; it < 256; it += G) {
                const int kind = it & 1, j = it >> 1, dir = j & 1, h = (j >> 1) & 7, b = j >> 4;
                if (kind == 0) ch::retention_chain(p, b, h, dir, (char*)shm); else ch::mlstm_chain(p, b, h, dir, (char*)shm);
                __syncthreads();
            }
        } break;
        case 15: if constexpr (PHON(15) && PH == 15) { phase_combine(p); } break;
        case 16: if constexpr (PHON(16) && PH == 16) {
            pg8::Gemm g{(const bf16_t*)(ws + A_MIXIN1), (const bf16_t*)(ws + W_WOUT1), 2048, 2048, 2048, 64, 8, 1, 0, 0};
            pg8::EpiBf16<0> E{X, 2048};
            pg8::gemm_phase(lds, g, E);
        } break;
        case 17: if constexpr (PHON(17) && PH == 17) { phase_norm<0>(p, NREAL, p.in[2] + 5 * DM, p.in[2] + 6 * DM, nullptr, 0, rep ? 0.f : 1.f); } break;
        case 18: if constexpr (PHON(18) && PH == 18) {
            pg8::Gemm g{X, (const bf16_t*)(ws + W_W1T), 2048, 2048, 2048, 64, 32, 1, 0, 0};
            pg8::EpiBf16<1> E{(bf16_t*)(ws + A_MID), 8192};
            pg8::gemm_phase(lds, g, E);
        } break;
        case 19: if constexpr (PHON(19) && PH == 19) {
            pg8::Gemm g{(const bf16_t*)(ws + A_MID), (const bf16_t*)(ws + W_W2T), 8192, 8192, 8192, 64, 8, 1, 0, 0};
            pg8::EpiBf16<0> E{X, 2048};
            pg8::gemm_phase(lds, g, E);
        } break;
        case 20: if constexpr (PHON(20) && PH == 20) { phase_norm<1>(p, NREAL, p.in[2] + 7 * DM, p.in[2] + 7 * DM, nullptr, 0, rep ? 0.f : 1.f); } break;
        default: break;
    }
}

__global__ __launch_bounds__(512, 2) void mega(Params p_arg, int ph_lo, int ph_hi) {
    extern __shared__ __attribute__((aligned(16))) unsigned char shm[];
    cg::grid_group grid = cg::this_grid();
    volatile LAS unsigned* xst = (volatile LAS unsigned*)((LAS unsigned char*)shm + 141312);
    if (threadIdx.x < 2) xst[threadIdx.x] = 0u;
    __syncthreads();
    const Params* pq0 = (const Params*)__builtin_amdgcn_kernarg_segment_ptr();
    const XcdBarrier xb = xcd_barrier_post((unsigned*)(pq0->ws + T_CTR), xst);
#define STEP(n) if (ph_lo <= (n) && (n) < ph_hi) { if ((n) > ph_lo) { if ((n) == 1 && ph_hi > 4096) grid.sync();   xcd_barrier(xb); } \
        const Params* pq = (const Params*)__builtin_amdgcn_kernarg_segment_ptr(); asm volatile("" : "+s"(pq)); \
        if constexpr ((REP_MASK >> (n)) & 1u) { int nrep = 2; asm volatile("" : "+s"(nrep)); \
            for (int rep = 0; rep < nrep; ++rep) { __syncthreads(); asm volatile("" : "+s"(pq)); phase_body<n>(*pq, (LAS unsigned char*)shm, shm, rep); } } \
        else phase_body<n>(*pq, (LAS unsigned char*)shm, shm); }
    STEP(0) STEP(1) STEP(2) STEP(3) STEP(4) STEP(5) STEP(6) STEP(7) STEP(8) STEP(9) STEP(10)
    STEP(11) STEP(12) STEP(13) STEP(14) STEP(15) STEP(16) STEP(17) STEP(18) STEP(19) STEP(20)
#undef STEP
}

#ifndef MK_ONE_LAUNCH
#define MK_ONE_LAUNCH 1
#endif
extern "C" void kernel_launch(void* const* d_in, const int* in_sizes, int n_in, void* d_out, int out_size, void* d_ws, size_t ws_size, hipStream_t stream) {
    static int ready = 0;
    if (!ready) {
        if (ws_size < WS_NEED) fprintf(stderr, "kernel_launch: workspace too small: %zu < %zu\n", ws_size, (size_t)WS_NEED);
        if (hipFuncSetAttribute((const void*)mega, hipFuncAttributeMaxDynamicSharedMemorySize, LDS_BYTES) != hipSuccess) fprintf(stderr, "kernel_launch: hipFuncSetAttribute failed\n");
        ready = 1;
    }
    Params p{};
    for (int i = 0; i < 30; ++i) p.in[i] = (const float*)d_in[i];
    p.out = (float*)d_out; p.ws = (unsigned char*)d_ws;
#if MK_ONE_LAUNCH
    (void)hipMemsetAsync((unsigned char*)d_ws + T_CTR, 0, XCD_BAR_WORDS * 4, stream);
    int lo = 0, hi = NPHASE;
    void* args[] = {&p, &lo, &hi};
    hipError_t e = hipLaunchCooperativeKernel((const void*)mega, dim3(256), dim3(512), args, LDS_BYTES, stream);
    if (e != hipSuccess) fprintf(stderr, "cooperative launch failed: %s\n", hipGetErrorString(e));
#else
    for (int ph = 0; ph < NPHASE; ++ph) hipLaunchKernelGGL(mega, dim3(256), dim3(512), LDS_BYTES, stream, p, ph, ph + 1);
#endif
}
```

```cpp
#include <hip/hip_runtime.h>
#include <hip/hip_cooperative_groups.h>
#include <stdint.h>
#include <cstdio>
namespace cg = cooperative_groups;

typedef unsigned short bf16_t;
typedef short bf16x8 __attribute__((ext_vector_type(8)));
typedef short s16x4 __attribute__((ext_vector_type(4)));
typedef float f32x2 __attribute__((ext_vector_type(2)));
typedef float f32x4 __attribute__((ext_vector_type(4)));
typedef float f32x16 __attribute__((ext_vector_type(16)));
typedef unsigned u32x2 __attribute__((ext_vector_type(2)));
typedef unsigned u32x4 __attribute__((ext_vector_type(4)));
#define LAS __attribute__((address_space(3)))
#define DEVI __device__ __forceinline__

constexpr int NB = 8, LSEQ = 2064, NTOK = 16512, MP = 16640, NREAL = 16384, DM = 2048, DFF = 8192;
constexpr int LPAD = 2176;
constexpr int QROWS = 6400;
constexpr float EPS = 1e-6f;

constexpr size_t U_ = 34078720ull;
constexpr size_t W_W1T = 0, W_W2T = 33554432ull, W_WINT = 67108864ull;
constexpr size_t W_WOUT0 = W_WINT + 12582912ull, W_GLUT = W_WOUT0 + 8388608ull, W_S5E = W_GLUT + 524288ull, W_S5WY = W_S5E + 4194304ull,
                 W_APOW = W_S5WY + 8388608ull, W_BBAR = W_APOW + 557056ull, W_KD = W_BBAR + 524288ull;
constexpr size_t W_WOUT1 = W_WINT + 26214400ull, W_MLW = W_WOUT1 + 8388608ull;
constexpr size_t TBL = 104857600ull;
constexpr size_t T_ROPEL = TBL, T_ROPEA = T_ROPEL + 1056768ull, T_HMETA = T_ROPEA + 1056768ull, T_GATES = T_HMETA + 2097152ull,
                 T_GA = T_GATES + 2129920ull, T_GPM = T_GA + 1114112ull, T_GBT = T_GPM + 1114112ull, T_CTR = T_GBT + 1114112ull;
constexpr size_t AR = TBL + 10485760ull;
constexpr size_t A_X = AR, A_MID = AR + 2 * U_;
constexpr size_t A_PROJ0 = AR + 2 * U_, A_QB = AR + 5 * U_, A_KB = A_QB + 54525952ull, A_VB = A_KB + 18743296ull, A_MIXIN0 = A_VB + 18743296ull,
                 A_A2 = AR + 10 * U_, A_S = A_X, A_YS = A_X + 42598400ull;
constexpr size_t A_RQ = AR + 2 * U_, A_RK = AR + 3 * U_, A_RV = AR + 4 * U_, A_RG = AR + 5 * U_, A_MU = AR + 6 * U_, A_MO = AR + 7 * U_,
                 A_MQKV = AR + 8 * U_, A_T0 = AR, A_T1 = AR + U_, A_T2 = A_MU, A_T3 = AR + 11 * U_, A_UCMU = AR, A_MIXIN1 = A_RQ;
constexpr size_t A_PT = AR + 10 * U_;
constexpr size_t WS_NEED = AR + 12 * U_;
static_assert(A_MIXIN0 + 2 * U_ <= AR + 10 * U_, "layer0 map");
static_assert(T_CTR + 16384 <= AR, "tbl map");

struct Params { const float* in[30]; float* out; unsigned char* ws; };

typedef _Float16 f16x2 __attribute__((ext_vector_type(2)));
typedef _Float16 f16x8 __attribute__((ext_vector_type(8)));
#define H8(x) __builtin_bit_cast(f16x8, (x))
DEVI unsigned cvtpk(float lo, float hi) { f16x2 v = {(_Float16)lo, (_Float16)hi}; return __builtin_bit_cast(unsigned, v); }
DEVI bf16_t f2bf(float f) { return __builtin_bit_cast(unsigned short, (_Float16)f); }
DEVI float bf2f(bf16_t b) { return (float)__builtin_bit_cast(_Float16, b); }
DEVI float bflo(unsigned w) { return (float)__builtin_bit_cast(f16x2, w)[0]; }
DEVI float bfhi(unsigned w) { return (float)__builtin_bit_cast(f16x2, w)[1]; }
DEVI int row_of(int b, int l) { return l < 16 ? NREAL + b * 16 + l : b * 2048 + (l - 16); }
DEVI void bl_of(int r, int& b, int& l) { if (r < NREAL) { b = r >> 11; l = 16 + (r & 2047); } else { const int m = r - NREAL; b = m >> 4; l = m & 15; } }
DEVI float* hrow(const Params& p, int r) { return r < NREAL ? p.out + (size_t)r * DM : (float*)(p.ws + T_HMETA) + (size_t)(r - NREAL) * DM; }
DEVI float wave_sum(float v) {
#pragma unroll
    for (int o = 32; o > 0; o >>= 1) v += __shfl_xor(v, o);
    return v;
}
DEVI float sigmoidf_(float x) { return 1.f / (1.f + __expf(-x)); }
DEVI void sincos_rr(float x, float& s, float& c) {
    const float k = rintf(x * 0.15915494309189535f);
    float r = fmaf(-k, 6.2831854820251465f, x); r = fmaf(k, 1.7484555e-7f, r);
    s = __sinf(r); c = __cosf(r);
}
DEVI float gelu_tanh(float x) { const float u = 0.7978845608028654f * (x + 0.044715f * x * x * x); const float t = 1.f - 2.f / (1.f + __expf(2.f * u)); return 0.5f * x * (1.f + t); }

namespace pg8 {
constexpr int BM = 256, BK = 64, HALF = 128, HTB = HALF * BK * 2, STAGE_BYTES = 8 * HTB, NXCD = 8, WGM = 4;
DEVI int lds_byte(int r, int c) { const int st = (r >> 4) * 2 + (c >> 5), rr = r & 15, cc = c & 31, ob = rr * 64 + cc * 2; return st * 1024 + (ob ^ (((ob >> 9) & 1) << 5)); }
DEVI void stage_rc(int b, int& R, int& C) { const int st = b / 1024, sb = b % 1024, swz = sb ^ (((sb >> 9) & 1) << 5); R = (st >> 1) * 16 + swz / 64; C = (st & 1) * 32 + (swz % 64) / 2; }
DEVI int perm32(int rho) { const int n = rho >> 4, i = rho & 15; return 8 * (i >> 2) + 4 * n + (i & 3); }
struct Unit { int pm, pn, bz; };
struct Gemm { const bf16_t* A; const bf16_t* Bt; int lda, ldb, K, nM, nN, nB; size_t sA, sB; };
struct Order {
    int nM, nN, nwg, tot, G, c;
    DEVI void init(const Gemm& g, int G_, int c_) { nM = g.nM; nN = g.nN; nwg = nM * nN; tot = nwg * g.nB; G = G_; c = c_; }
    DEVI bool next(int i, Unit& u) const {
        const long L = (long)i * G + c; if (L >= tot) return false;
        u.bz = (int)(L / nwg); int wgid = (int)(L % nwg);
        { const int q = nwg / NXCD, r = nwg % NXCD, xcd = wgid % NXCD, off = wgid / NXCD; wgid = (xcd < r ? xcd * (q + 1) : r * (q + 1) + (xcd - r) * q) + off; }
        const int nig = WGM * nN, gid = wgid / nig, fm = gid * WGM, gsz = (nM - fm) < WGM ? (nM - fm) : WGM;
        u.pm = fm + ((wgid % nig) % gsz); u.pn = (wgid % nig) / gsz; return true;
    }
};
template <class Epi>
DEVI void gemm_phase(LAS unsigned char* lds, const Gemm g, const Epi& E) {
    const int tid = threadIdx.x, wid = __builtin_amdgcn_readfirstlane(tid >> 6), lane = tid & 63, wr = wid >> 2, wc = wid & 3, fr = lane & 15, fq = lane >> 4;
    const int K = g.K, nt = K / BK;
    Order S; S.init(g, (int)gridDim.x, (int)blockIdx.x);
    unsigned voffA[2], voffB[2];
#pragma unroll
    for (int i = 0; i < 2; ++i) { int R, C; stage_rc(tid * 16 + i * 8192, R, C); const int Rb = Epi::PERM ? ((R & ~31) + perm32(R & 31)) : R;
        voffA[i] = (unsigned)(R * g.lda + C) * 2u; voffB[i] = (unsigned)(Rb * g.ldb + C) * 2u; }
    const size_t kstep = (size_t)(BK * 2);
    const size_t hstepA = (size_t)HALF * g.lda * 2, hstepB = (size_t)HALF * g.ldb * 2;
    const unsigned ldsw = (unsigned)wid * 1024u;
    const int aoff = lds_byte(wr * 64 + fr, fq * 8), boff = lds_byte(wc * 32 + fr, fq * 8);
#define PG8_SA(b, h) (((b) * 2 + (h)) * HTB)
#define PG8_SB(b, h) ((4 + (b) * 2 + (h)) * HTB)
#define PG8_STAGE(bufoff, gbase, voff) do { _Pragma("unroll") for (int _i = 0; _i < 2; ++_i) \
        __builtin_amdgcn_global_load_lds((const unsigned*)((const char*)(gbase) + (voff)[_i]), (LAS unsigned*)(lds + (bufoff) + ldsw + _i * 8192), 16, 0, 0); } while (0)
#define PG8_LDA(dst, b, h) do { _Pragma("unroll") for (int m = 0; m < 4; ++m) _Pragma("unroll") for (int k = 0; k < 2; ++k) dst[m][k] = *(const LAS bf16x8*)(lds + PG8_SA(b, h) + aoff + m * 2048 + k * 1024); } while (0)
#define PG8_LDB(dst, b, h) do { _Pragma("unroll") for (int n = 0; n < 2; ++n) _Pragma("unroll") for (int k = 0; k < 2; ++k) dst[n][k] = *(const LAS bf16x8*)(lds + PG8_SB(b, h) + boff + n * 2048 + k * 1024); } while (0)
#define PG8_MMA(ai, bj, At, Bt) do { __builtin_amdgcn_s_setprio(1); _Pragma("unroll") for (int m = 0; m < 4; ++m) _Pragma("unroll") for (int n = 0; n < 2; ++n) _Pragma("unroll") for (int k = 0; k < 2; ++k) \
        acc[ai][bj][m][n] = __builtin_amdgcn_mfma_f32_16x16x32_f16(H8(Bt[n][k]), H8(At[m][k]), acc[ai][bj][m][n], 0, 0, 0); __builtin_amdgcn_s_setprio(0); } while (0)
#define PG8_WAIT_V(n) asm volatile("s_waitcnt vmcnt(" #n ")" ::: "memory")
#define PG8_WAIT_L(n) asm volatile("s_waitcnt lgkmcnt(" #n ")" ::: "memory")
#define PG8_BAR __builtin_amdgcn_s_barrier()
#define PG8_SCHED __builtin_amdgcn_sched_barrier(0)
    Unit cur, nxt; int ui = 0;
    if (!S.next(0, cur)) return;
    f32x4 acc[2][2][4][2];
#pragma unroll
    for (int a = 0; a < 2; ++a)
#pragma unroll
        for (int b = 0; b < 2; ++b)
#pragma unroll
            for (int m = 0; m < 4; ++m)
#pragma unroll
                for (int n = 0; n < 2; ++n) acc[a][b][m][n] = (f32x4){0.f, 0.f, 0.f, 0.f};
    bf16x8 At[4][2], B0[2][2], B1[2][2];
    const char* cA = (const char*)g.A + ((size_t)cur.bz * g.sA) * 2 + (size_t)cur.pm * 2 * hstepA;
    const char* cB = (const char*)g.Bt + ((size_t)cur.bz * g.sB) * 2 + (size_t)cur.pn * 2 * hstepB;
    PG8_STAGE(PG8_SB(0, 0), cB, voffB); PG8_STAGE(PG8_SA(0, 0), cA, voffA); PG8_STAGE(PG8_SB(0, 1), cB + hstepB, voffB); PG8_STAGE(PG8_SA(0, 1), cA + hstepA, voffA);
    if (wr == 1) PG8_BAR;
    PG8_WAIT_V(4); PG8_BAR;
    PG8_STAGE(PG8_SB(1, 0), cB + kstep, voffB); PG8_STAGE(PG8_SA(1, 0), cA + kstep, voffA); PG8_STAGE(PG8_SB(1, 1), cB + hstepB + kstep, voffB);
    PG8_WAIT_V(6); PG8_BAR;
    for (;;) {
        const bool has_next = S.next(ui + 1, nxt);
        const char* nA = has_next ? (const char*)g.A + ((size_t)nxt.bz * g.sA) * 2 + (size_t)nxt.pm * 2 * hstepA : cA;
        const char* nB = has_next ? (const char*)g.Bt + ((size_t)nxt.bz * g.sB) * 2 + (size_t)nxt.pn * 2 * hstepB : cB;
#pragma unroll 1
        for (int t = 0; t < nt; t += 2) {
            const bool last = (t == nt - 2);
            const char* a1 = cA + (size_t)(t + 1) * kstep;
            const char* a2 = last ? nA : cA + (size_t)(t + 2) * kstep; const char* b2 = last ? nB : cB + (size_t)(t + 2) * kstep;
            const char* a3 = a2 + kstep; const char* b3 = b2 + kstep;
            PG8_LDB(B0, 0, 0); PG8_SCHED; PG8_LDA(At, 0, 0); PG8_STAGE(PG8_SA(1, 1), a1 + hstepA, voffA);
            PG8_WAIT_L(8); PG8_BAR; PG8_WAIT_L(0); PG8_MMA(0, 0, At, B0); PG8_BAR; PG8_SCHED;
            PG8_LDB(B1, 0, 1); PG8_STAGE(PG8_SB(0, 0), b2, voffB);
            PG8_BAR; PG8_WAIT_L(0); PG8_MMA(0, 1, At, B1); PG8_BAR;
            PG8_LDA(At, 0, 1); PG8_STAGE(PG8_SA(0, 0), a2, voffA);
            PG8_BAR; PG8_WAIT_L(0); PG8_MMA(1, 0, At, B0); PG8_BAR; PG8_SCHED;
            PG8_STAGE(PG8_SB(0, 1), b2 + hstepB, voffB);
            PG8_WAIT_V(6); PG8_BAR; PG8_MMA(1, 1, At, B1); PG8_BAR;
            PG8_LDB(B0, 1, 0); PG8_SCHED; PG8_LDA(At, 1, 0); PG8_STAGE(PG8_SA(0, 1), a2 + hstepA, voffA);
            PG8_WAIT_L(8); PG8_BAR; PG8_WAIT_L(0); PG8_MMA(0, 0, At, B0); PG8_BAR; PG8_SCHED;
            PG8_LDB(B1, 1, 1); PG8_STAGE(PG8_SB(1, 0), b3, voffB);
            PG8_BAR; PG8_WAIT_L(0); PG8_MMA(0, 1, At, B1); PG8_BAR;
            PG8_LDA(At, 1, 1); PG8_STAGE(PG8_SA(1, 0), a3, voffA);
            PG8_BAR; PG8_WAIT_L(0); PG8_MMA(1, 0, At, B0); PG8_BAR; PG8_SCHED;
            PG8_STAGE(PG8_SB(1, 1), b3 + hstepB, voffB);
            PG8_WAIT_V(6); PG8_BAR; PG8_MMA(1, 1, At, B1); PG8_BAR;
        }
        E(acc, cur, wr, wc, fr, fq);
        if (!has_next) break;
#pragma unroll
        for (int a = 0; a < 2; ++a)
#pragma unroll
            for (int b = 0; b < 2; ++b)
#pragma unroll
                for (int m = 0; m < 4; ++m)
#pragma unroll
                    for (int n = 0; n < 2; ++n) acc[a][b][m][n] = (f32x4){0.f, 0.f, 0.f, 0.f};
        cur = nxt; cA = nA; cB = nB; ++ui;
    }
    PG8_WAIT_V(0);
    if (wr == 0) PG8_BAR;
    PG8_BAR;
#undef PG8_SA
#undef PG8_SB
#undef PG8_STAGE
#undef PG8_LDA
#undef PG8_LDB
#undef PG8_MMA
#undef PG8_WAIT_V
#undef PG8_WAIT_L
#undef PG8_BAR
#undef PG8_SCHED
}

template <class F> DEVI void epi8(const f32x4 (&acc)[2][2][4][2], const Unit& u, int wr, int wc, int fr, int fq, const F& f) {
    const int row0 = u.pm * BM + wr * 64 + fr, col0 = u.pn * BM + wc * 32 + 8 * fq;
#pragma unroll
    for (int ai = 0; ai < 2; ++ai)
#pragma unroll
        for (int m = 0; m < 4; ++m)
#pragma unroll
            for (int bj = 0; bj < 2; ++bj) f(row0 + ai * HALF + m * 16, col0 + bj * HALF, acc[ai][bj][m][0], acc[ai][bj][m][1]);
}
DEVI u32x4 pack8(f32x4 v0, f32x4 v1) { u32x4 w; w.x = cvtpk(v0[0], v0[1]); w.y = cvtpk(v0[2], v0[3]); w.z = cvtpk(v1[0], v1[1]); w.w = cvtpk(v1[2], v1[3]); return w; }

template <int ACT  > struct EpiBf16 {
    static constexpr bool PERM = true;
    bf16_t* O; int ldc;
    DEVI void operator()(const f32x4 (&acc)[2][2][4][2], const Unit& u, int wr, int wc, int fr, int fq) const {
        epi8(acc, u, wr, wc, fr, fq, [&](int row, int col, f32x4 v0, f32x4 v1) {
            if (ACT == 1) {
#pragma unroll
                for (int j = 0; j < 4; ++j) { const float a = fmaxf(v0[j], 0.f), b = fmaxf(v1[j], 0.f); v0[j] = a * a; v1[j] = b * b; } }
            *(u32x4*)(O + (size_t)row * ldc + col) = pack8(v0, v1); });
    }
};
struct EpiWin0 {
    static constexpr bool PERM = true;
    bf16_t* proj; bf16_t* a2;
    DEVI void operator()(const f32x4 (&acc)[2][2][4][2], const Unit& u, int wr, int wc, int fr, int fq) const {
        epi8(acc, u, wr, wc, fr, fq, [&](int row, int col, f32x4 v0, f32x4 v1) {
            const u32x4 w = pack8(v0, v1);
            if (col < 2560) { *(u32x4*)(proj + (size_t)row * 2560 + col) = w; }
            else if (row < NTOK) {
                int b, l; bl_of(row, b, l); const int cid = b * 129 + (l >> 4), i = l & 15, cc = col - 2560, gg = cc >> 4, h8 = cc & 15;
                *(u32x4*)(a2 + ((size_t)gg * 1280 + cid) * 512 + i * 16 + h8) = w; } });
    }
};
struct EpiF32 {
    static constexpr bool PERM = false;
    float* C; int ldc; size_t sC;
    DEVI void operator()(const f32x4 (&acc)[2][2][4][2], const Unit& u, int wr, int wc, int fr, int fq) const {
        const int row0 = u.pm * BM + wr * 64 + fr, col0 = u.pn * BM + wc * 32 + 4 * fq; float* Cb = C + (size_t)u.bz * sC;
#pragma unroll
        for (int ai = 0; ai < 2; ++ai)
#pragma unroll
            for (int m = 0; m < 4; ++m) { float* rowp = Cb + (size_t)(row0 + ai * HALF + m * 16) * ldc + col0;
#pragma unroll
                for (int bj = 0; bj < 2; ++bj)
#pragma unroll
                    for (int n = 0; n < 2; ++n) *(f32x4*)(rowp + bj * HALF + n * 16) = acc[ai][bj][m][n]; }
    }
};
struct EpiPart {
    static constexpr bool PERM = false;
    float* P;
    DEVI void operator()(const f32x4 (&acc)[2][2][4][2], const Unit& u, int wr, int wc, int fr, int fq) const {
        const int row0 = wr * 64 + fr, col0 = u.pn * BM + wc * 32 + 4 * fq; float* Pb = P + (size_t)u.bz * 128 * 2048;
#pragma unroll
        for (int m = 0; m < 4; ++m) { float* rowp = Pb + (size_t)(row0 + m * 16) * 2048 + col0;
#pragma unroll
            for (int bj = 0; bj < 2; ++bj)
#pragma unroll
                for (int n = 0; n < 2; ++n) *(f32x4*)(rowp + bj * HALF + n * 16) = acc[0][bj][m][n]; }
    }
};
struct EpiS5Y {
    static constexpr bool PERM = true;
    bf16_t* ys;
    DEVI void operator()(const f32x4 (&acc)[2][2][4][2], const Unit& u, int wr, int wc, int fr, int fq) const {
        epi8(acc, u, wr, wc, fr, fq, [&](int cid, int col, f32x4 v0, f32x4 v1) {
            if (cid < 1032) { const int b = cid / 129, c = cid - b * 129, i = col >> 4, h8 = col & 15; const int row = row_of(b, c * 16 + i);
#pragma unroll
                for (int j = 0; j < 4; ++j) { v0[j] = gelu_tanh(v0[j]); v1[j] = gelu_tanh(v1[j]); }
                *(u32x4*)(ys + (size_t)row * 512 + u.bz * 16 + h8) = pack8(v0, v1); } });
    }
};
struct EpiGlu {
    static constexpr bool PERM = true;
    const bf16_t* ys; const float* bias; bf16_t* mixin;
    DEVI void operator()(const f32x4 (&acc)[2][2][4][2], const Unit& u, int wr, int wc, int fr, int fq) const {
        epi8(acc, u, wr, wc, fr, fq, [&](int row, int col, f32x4 v0, f32x4 v1) {
            const u32x4 y = *(const u32x4*)(ys + (size_t)row * 512 + col); const f32x4 b0 = *(const f32x4*)(bias + col), b1 = *(const f32x4*)(bias + col + 4);
            const float yy[8] = {bflo(y.x), bfhi(y.x), bflo(y.y), bfhi(y.y), bflo(y.z), bfhi(y.z), bflo(y.w), bfhi(y.w)};
#pragma unroll
            for (int j = 0; j < 4; ++j) { v0[j] = yy[j] * sigmoidf_(v0[j] + b0[j]); v1[j] = yy[4 + j] * sigmoidf_(v1[j] + b1[j]); }
            *(u32x4*)(mixin + (size_t)row * 2048 + 1536 + col) = pack8(v0, v1); });
    }
};
struct EpiWin1 {
    static constexpr bool PERM = true;
    bf16_t* base; float* gates;
    DEVI void operator()(const f32x4 (&acc)[2][2][4][2], const Unit& u, int wr, int wc, int fr, int fq) const {
        epi8(acc, u, wr, wc, fr, fq, [&](int row, int col, f32x4 v0, f32x4 v1) {
            if (col < 6144) { const int t = col >> 10; *(u32x4*)(base + (size_t)t * (U_ / 2) + (size_t)row * 1024 + (col & 1023)) = pack8(v0, v1); }
            else if (col < 6176) { float* gp = gates + (size_t)row * 32 + (col - 6144); *(f32x4*)gp = v0; *(f32x4*)(gp + 4) = v1; } });
    }
};
struct EpiMqkv {
    static constexpr bool PERM = true;
    bf16_t* O;
    DEVI void operator()(const f32x4 (&acc)[2][2][4][2], const Unit& u, int wr, int wc, int fr, int fq) const {
        const int row0 = u.pm * BM + wr * 64 + fr, col0 = u.pn * BM + wc * 32 + 8 * fq;
        bf16_t* base = O + (size_t)row0 * 3072 + u.bz * 384 + col0;
        const int nbj = u.pn == 0 ? 2 : 1;
#pragma unroll
        for (int ai = 0; ai < 2; ++ai)
#pragma unroll
            for (int m = 0; m < 4; ++m)
#pragma unroll
                for (int bj = 0; bj < 2; ++bj) if (bj < nbj) *(u32x4*)(base + (size_t)(ai * HALF + m * 16) * 3072 + bj * HALF) = pack8(acc[ai][bj][m][0], acc[ai][bj][m][1]);
    }
};
}

DEVI void tcvt_job(const float* __restrict__ src, int R, int C, bf16_t* __restrict__ dst, int ldd, float* tile  , int bid = -1, int nb = 0) {
    const int tr = R / 64, tc = (C + 63) / 64, nt = tr * tc, tid = threadIdx.x;
    if (bid < 0) { bid = blockIdx.x; nb = gridDim.x; }
    for (int t0 = bid * 4; t0 < nt; t0 += nb * 4) {
        __syncthreads();
        f32x4 v[4][2];
#pragma unroll
        for (int q = 0; q < 4; ++q) { const int t = t0 + q; const int r0 = (t / tc) * 64, c0 = (t % tc) * 64;
#pragma unroll
            for (int k = 0; k < 2; ++k) { const int r = (tid >> 4) + 32 * k, c4 = (tid & 15) * 4;
                v[q][k] = (f32x4){0.f, 0.f, 0.f, 0.f};
                if (t < nt && c0 + c4 < C) v[q][k] = *(const f32x4*)(src + (size_t)(r0 + r) * C + c0 + c4); } }
#pragma unroll
        for (int q = 0; q < 4; ++q)
#pragma unroll
            for (int k = 0; k < 2; ++k) { const int r = (tid >> 4) + 32 * k, c4 = (tid & 15) * 4; float* tp = tile + q * 4160 + r * 65 + c4;
                tp[0] = v[q][k][0]; tp[1] = v[q][k][1]; tp[2] = v[q][k][2]; tp[3] = v[q][k][3]; }
        __syncthreads();
#pragma unroll
        for (int q = 0; q < 4; ++q) { const int t = t0 + q; const int r0 = (t / tc) * 64, c0 = (t % tc) * 64; const float* tq = tile + q * 4160;
            const int c = tid >> 3, r8 = (tid & 7) * 8;
            if (t < nt && c0 + c < C) { u32x4 w; w.x = cvtpk(tq[(r8 + 0) * 65 + c], tq[(r8 + 1) * 65 + c]); w.y = cvtpk(tq[(r8 + 2) * 65 + c], tq[(r8 + 3) * 65 + c]);
                w.z = cvtpk(tq[(r8 + 4) * 65 + c], tq[(r8 + 5) * 65 + c]); w.w = cvtpk(tq[(r8 + 6) * 65 + c], tq[(r8 + 7) * 65 + c]);
                *(u32x4*)(dst + (size_t)(c0 + c) * ldd + r0 + r8) = w; } }
    }
    __syncthreads();
}

DEVI void phase_init_h(const Params& p, const float* gain) {
    const int wid = threadIdx.x >> 6, lane = threadIdx.x & 63;
    bf16_t* X = (bf16_t*)(p.ws + A_X);
    for (int r = blockIdx.x * 8 + wid; r < NTOK; r += gridDim.x * 8) {
        int b, l; bl_of(r, b, l);
        const float* src = l < 16 ? p.in[1] + (size_t)l * DM : p.in[0] + ((size_t)b * 2048 + (l - 16)) * DM;
        float* hp = hrow(p, r);
        f32x4 v[8]; float ss = 0.f;
#pragma unroll
        for (int j = 0; j < 8; ++j) { v[j] = *(const f32x4*)(src + j * 256 + lane * 4); ss += v[j][0] * v[j][0] + v[j][1] * v[j][1] + v[j][2] * v[j][2] + v[j][3] * v[j][3]; }
        ss = wave_sum(ss); const float rs = rsqrtf(ss * (1.f / DM) + EPS);
#pragma unroll
        for (int j = 0; j < 8; ++j) { if (r >= NREAL) *(f32x4*)(hp + j * 256 + lane * 4) = v[j]; const f32x4 g = *(const f32x4*)(gain + j * 256 + lane * 4);
            u32x2 w; w.x = cvtpk(v[j][0] * rs * g[0], v[j][1] * rs * g[1]); w.y = cvtpk(v[j][2] * rs * g[2], v[j][3] * rs * g[3]);
            *(u32x2*)(X + (size_t)r * DM + j * 256 + lane * 4) = w; }
    }
}
template <int MODE> DEVI void phase_norm(const Params& p, int nrows, const float* g1, const float* g2, const float* PT = nullptr, int nsplit = 0, float addscale = 1.f, const float* hin = nullptr) {
    const int wid = threadIdx.x >> 6, lane = threadIdx.x & 63;
    bf16_t* X = (bf16_t*)(p.ws + A_X);
    for (int r = blockIdx.x * 8 + wid; r < nrows; r += gridDim.x * 8) {
        float* hp = hrow(p, r); bf16_t* xp = X + (size_t)r * DM;
        const float* hr = (hin && r < NREAL) ? hin + (size_t)r * DM : hp;
        float y[32]; float ss = 0.f;
        if (PT && r >= NREAL) {
#pragma unroll
            for (int j = 0; j < 32; ++j) y[j] = 0.f;
            for (int sp = 0; sp < nsplit; ++sp) { const float* pr = PT + ((size_t)sp * 128 + (r - NREAL)) * 2048;
#pragma unroll
                for (int j = 0; j < 4; ++j) { const f32x4 a = *(const f32x4*)(pr + j * 512 + lane * 8), bq = *(const f32x4*)(pr + j * 512 + lane * 8 + 4);
#pragma unroll
                    for (int e = 0; e < 4; ++e) { y[j * 8 + e] += a[e]; y[j * 8 + 4 + e] += bq[e]; } } }
        } else
#pragma unroll
        for (int j = 0; j < 4; ++j) { const u32x4 w = *(const u32x4*)(xp + j * 512 + lane * 8);
            y[j * 8 + 0] = bflo(w.x); y[j * 8 + 1] = bfhi(w.x); y[j * 8 + 2] = bflo(w.y); y[j * 8 + 3] = bfhi(w.y);
            y[j * 8 + 4] = bflo(w.z); y[j * 8 + 5] = bfhi(w.z); y[j * 8 + 6] = bflo(w.w); y[j * 8 + 7] = bfhi(w.w); }
#pragma unroll
        for (int j = 0; j < 32; ++j) ss += y[j] * y[j];
        ss = wave_sum(ss); const float rs = rsqrtf(ss * (1.f / DM) + EPS) * addscale;
        float s2 = 0.f;
#pragma unroll
        for (int j = 0; j < 4; ++j)
#pragma unroll
            for (int q = 0; q < 2; ++q) { const int c = j * 512 + lane * 8 + q * 4; const f32x4 hv = *(const f32x4*)(hr + c), gv = *(const f32x4*)(g1 + c);
#pragma unroll
                for (int e = 0; e < 4; ++e) { const float hn = hv[e] + y[j * 8 + q * 4 + e] * rs * gv[e]; y[j * 8 + q * 4 + e] = hn; s2 += hn * hn; } }
#pragma unroll
        for (int j = 0; j < 4; ++j)
#pragma unroll
            for (int q = 0; q < 2; ++q) { const int c = j * 512 + lane * 8 + q * 4; *(f32x4*)(hp + c) = (f32x4){y[j * 8 + q * 4], y[j * 8 + q * 4 + 1], y[j * 8 + q * 4 + 2], y[j * 8 + q * 4 + 3]}; }
        if (MODE == 0) {
            s2 = wave_sum(s2); const float r2 = rsqrtf(s2 * (1.f / DM) + EPS);
#pragma unroll
            for (int j = 0; j < 4; ++j) { const int c = j * 512 + lane * 8; const f32x4 ga = *(const f32x4*)(g2 + c), gb = *(const f32x4*)(g2 + c + 4);
                u32x4 w; w.x = cvtpk(y[j * 8] * r2 * ga[0], y[j * 8 + 1] * r2 * ga[1]); w.y = cvtpk(y[j * 8 + 2] * r2 * ga[2], y[j * 8 + 3] * r2 * ga[3]);
                w.z = cvtpk(y[j * 8 + 4] * r2 * gb[0], y[j * 8 + 5] * r2 * gb[1]); w.w = cvtpk(y[j * 8 + 6] * r2 * gb[2], y[j * 8 + 7] * r2 * gb[3]);
                *(u32x4*)(xp + c) = w; }
        }
    }
}

DEVI void phase_tables(const Params& p) {
    const int gt = blockIdx.x * 512 + threadIdx.x, gs = gridDim.x * 512;
    float* rl = (float*)(p.ws + T_ROPEL); float* ra = (float*)(p.ws + T_ROPEA);
    for (int i = gt; i < LSEQ * 64; i += gs) {
        const int l = i >> 6, j = i & 63; float s, c;
        const float fl = __expf(-(float)j * (1.f / 64.f) * 9.210340371976184f);
        sincos_rr((float)l * fl, s, c); rl[i * 2] = c; rl[i * 2 + 1] = s;
        const float fa = __expf(-(float)(j & 31) * (1.f / 32.f) * 9.210340371976184f);
        float pos; if (l < 16) pos = (j < 32) ? -1.f : (float)l; else { const int n = l - 16; pos = (j < 32) ? (float)(n >> 6) : (float)(n & 63); }
        sincos_rr(pos * fa, s, c); ra[i * 2] = c; ra[i * 2 + 1] = s;
    }
    float* ap = (float*)(p.ws + W_APOW); float* bb = (float*)(p.ws + W_BBAR);
    for (int i = gt; i < 32 * 2 * 64; i += gs) {
        const int pp = i & 63, dir = (i >> 6) & 1, g = i >> 7; const int li_ = (dir * 32 + g) * 64 + pp;
        const float lr = fminf(p.in[9][li_], -1e-4f), li = p.in[10][li_], dt = __expf(p.in[11][dir * 32 + g]);
        for (int d = 0; d <= 16; ++d) { float s, c; sincos_rr(li * dt * (float)d, s, c); const float e = __expf(lr * dt * (float)d);
            float* o = ap + ((((size_t)g * 2 + dir) * 17 + d) * 64 + pp) * 2; o[0] = e * c; o[1] = e * s; }
        float s, c; sincos_rr(li * dt, s, c); const float er = __expf(lr * dt), are = er * c, aim = er * s;
        const float nr = are - 1.f, den = lr * lr + li * li, cre = (nr * lr + aim * li) / den, cim = (aim * lr - nr * li) / den;
        for (int h = 0; h < 16; ++h) { const float br = p.in[12][(size_t)li_ * 16 + h], bi = p.in[13][(size_t)li_ * 16 + h];
            float* o = bb + ((((size_t)g * 2 + dir) * 64 + pp) * 16 + h) * 2; o[0] = cre * br - cim * bi; o[1] = cre * bi + cim * br; }
    }
}
DEVI void phase_s5_build(const Params& p) {
    const int gt = blockIdx.x * 512 + threadIdx.x, gs = gridDim.x * 512;
    const float* ap = (const float*)(p.ws + W_APOW); const float* bb = (const float*)(p.ws + W_BBAR);
    bf16_t* E = (bf16_t*)(p.ws + W_S5E);
    for (int i = gt; i < 32 * 256 * 256; i += gs) {
        const int k = i & 255, n = (i >> 8) & 255, g = i >> 16; const int dir = n >> 7, part = (n >> 6) & 1, pp = n & 63, j = k >> 4, h = k & 15;
        const int d = dir ? j : 15 - j;
        const float* a = ap + ((((size_t)g * 2 + dir) * 17 + d) * 64 + pp) * 2; const float* b = bb + ((((size_t)g * 2 + dir) * 64 + pp) * 16 + h) * 2;
        const float re = a[0] * b[0] - a[1] * b[1], im = a[0] * b[1] + a[1] * b[0];
        E[i] = f2bf(part ? im : re);
    }
    float* KD = (float*)(p.ws + W_KD);
    for (int i = gt; i < 32 * 2 * 16 * 256; i += gs) {
        const int hi = i & 15, ho = (i >> 4) & 15, d = (i >> 8) & 15, dir = (i >> 12) & 1, g = i >> 13;
        const float* a = ap + (((size_t)g * 2 + dir) * 17 + d) * 128; const float* b = bb + (((size_t)g * 2 + dir) * 64) * 32 + hi * 2;
        const float* cr = p.in[14] + (((size_t)dir * 32 + g) * 16 + ho) * 64; const float* ci = p.in[15] + (((size_t)dir * 32 + g) * 16 + ho) * 64;
        float v = 0.f;
        for (int pp = 0; pp < 64; ++pp) { const float are = a[pp * 2], aim = a[pp * 2 + 1], bre = b[pp * 32], bim = b[pp * 32 + 1];
            const float tre = are * bre - aim * bim, tim = are * bim + aim * bre; v += cr[pp] * tre - ci[pp] * tim; }
        KD[i] = v;
    }
}
DEVI void phase_s5_build2(const Params& p) {
    const int gt = blockIdx.x * 512 + threadIdx.x, gs = gridDim.x * 512;
    const float* ap = (const float*)(p.ws + W_APOW); const float* KD = (const float*)(p.ws + W_KD); bf16_t* Wy = (bf16_t*)(p.ws + W_S5WY);
    for (int i = gt; i < 32 * 256 * 512; i += gs) {
        const int k = i & 511, n = (i >> 9) & 255, g = i >> 17; const int ii = n >> 4, ho = n & 15; float v = 0.f;
        if (k < 256) { const int j = k >> 4, hi = k & 15;
            if (j <= ii) v += KD[((((size_t)g * 2 + 0) * 16 + (ii - j)) * 16 + ho) * 16 + hi];
            if (j >= ii) v += KD[((((size_t)g * 2 + 1) * 16 + (j - ii)) * 16 + ho) * 16 + hi];
            if (j == ii && hi == ho) v += p.in[16][g * 16 + ho];
        } else { const int kk = k - 256, dir = kk >> 7, part = (kk >> 6) & 1, pp = kk & 63; const int d = dir ? 16 - ii : ii + 1;
            const float* a = ap + ((((size_t)g * 2 + dir) * 17 + d) * 64 + pp) * 2;
            const float cr = p.in[14][(((size_t)dir * 32 + g) * 16 + ho) * 64 + pp], ci = p.in[15][(((size_t)dir * 32 + g) * 16 + ho) * 64 + pp];
            const float zre = cr * a[0] - ci * a[1], zim = cr * a[1] + ci * a[0]; v = part ? -zim : zre; }
        Wy[i] = f2bf(v);
    }
}
DEVI void phase_s5_scan(const Params& p) {
    const float* S = (const float*)(p.ws + A_S); bf16_t* A2 = (bf16_t*)(p.ws + A_A2); const float* ap = (const float*)(p.ws + W_APOW);
    for (int it = (int)blockIdx.x - 192; it >= 0 && it < 64; it += gridDim.x) {
        const int t = it * 512 + threadIdx.x; const int pp = t & 63, dir = (t >> 6) & 1, g = (t >> 7) & 31, b = t >> 12;
        const float* a = ap + ((((size_t)g * 2 + dir) * 17 + 16) * 64 + pp) * 2; const float are = a[0], aim = a[1];
        float xr = 0.f, xi = 0.f;
        const size_t rb = (size_t)g * 1280 + b * 129;
#pragma unroll 1
        for (int s0 = 0; s0 < 136; s0 += 8) {
            float sr[8], si[8];
#pragma unroll
            for (int k = 0; k < 8; ++k) { const int s = s0 + k; const int c = dir ? 128 - s : s; const bool ok = s < 129; const size_t cid = rb + (ok ? c : 0);
                sr[k] = ok ? S[cid * 256 + dir * 128 + pp] : 0.f; si[k] = ok ? S[cid * 256 + dir * 128 + 64 + pp] : 0.f; }
#pragma unroll
            for (int k = 0; k < 8; ++k) { const int s = s0 + k; const int c = dir ? 128 - s : s;
                if (s < 129) { bf16_t* xo = A2 + (rb + c) * 512 + 256 + dir * 128 + pp; xo[0] = f2bf(xr); xo[64] = f2bf(xi);
                    const float nr = are * xr - aim * xi + sr[k], ni = are * xi + aim * xr + si[k]; xr = nr; xi = ni; } }
        }
    }
}

DEVI void phase_qk(const Params& p) {
    const int wid = threadIdx.x >> 6, lane = threadIdx.x & 63;
    const bf16_t* proj = (const bf16_t*)(p.ws + A_PROJ0); bf16_t* Qb = (bf16_t*)(p.ws + A_QB); bf16_t* Kb = (bf16_t*)(p.ws + A_KB); bf16_t* Vb = (bf16_t*)(p.ws + A_VB);
    const float* ra = (const float*)(p.ws + T_ROPEA);
    const int t16 = lane & 15, sub = lane >> 4;
    for (int it0 = (blockIdx.x * 8 + wid) * 4; it0 < NTOK * 20; it0 += gridDim.x * 32) {
        const int it = it0 + sub; const int r = it / 20, hs = it - r * 20; int b, l; bl_of(r, b, l);
        const u32x4 w = *(const u32x4*)(proj + (size_t)r * 2560 + hs * 128 + t16 * 8);
        if (hs >= 16) { *(u32x4*)(Vb + (((size_t)b * 4 + (hs - 16)) * LPAD + l) * 128 + t16 * 8) = w; continue; }
        float x[8] = {bflo(w.x), bfhi(w.x), bflo(w.y), bfhi(w.y), bflo(w.z), bfhi(w.z), bflo(w.w), bfhi(w.w)};
        float ss = 0.f;
#pragma unroll
        for (int e = 0; e < 8; ++e) ss += x[e] * x[e];
        ss += __shfl_xor(ss, 8); ss += __shfl_xor(ss, 4); ss += __shfl_xor(ss, 2); ss += __shfl_xor(ss, 1);
        const float rs = rsqrtf(ss * (1.f / 128.f) + EPS);
        const float* gn = (hs < 12 ? p.in[7] : p.in[8]) + t16 * 8;
        const f32x4 g0 = *(const f32x4*)gn, g1 = *(const f32x4*)(gn + 4);
        const int jt = 32 * (t16 >> 3) + 8 * (t16 & 3);
        const float* cs = ra + ((size_t)l * 64 + jt) * 2;
        const bool lo = (t16 & 4) == 0;
        float o[8];
#pragma unroll
        for (int e = 0; e < 8; ++e) { const float y = x[e] * rs * (e < 4 ? g0[e] : g1[e - 4]); const float yp = __shfl_xor(y, 4);
            const float c = cs[2 * e], sn = cs[2 * e + 1]; o[e] = lo ? (y * c - yp * sn) : (yp * sn + y * c); }
        bf16_t* dst;
        if (hs < 12) { const int kv = hs / 3, gq = hs - kv * 3; dst = Qb + (((size_t)b * 4 + kv) * QROWS + gq * LSEQ + l) * 128; }
        else dst = Kb + (((size_t)b * 4 + (hs - 12)) * LPAD + l) * 128;
        u32x4 ow; ow.x = cvtpk(o[0], o[1]); ow.y = cvtpk(o[2], o[3]); ow.z = cvtpk(o[4], o[5]); ow.w = cvtpk(o[6], o[7]);
        *(u32x4*)(dst + t16 * 8) = ow;
    }
    for (int it = blockIdx.x * 512 + threadIdx.x; it < 32 * 112 * 16; it += gridDim.x * 512) {
        const int ch = it & 15, rr = (it >> 4) % 112, bk = it / (112 * 16);
        *(u32x4*)(Vb + ((size_t)bk * LPAD + LSEQ + rr) * 128 + ch * 8) = (u32x4){0u, 0u, 0u, 0u};
        *(u32x4*)(Kb + ((size_t)bk * LPAD + LSEQ + rr) * 128 + ch * 8) = (u32x4){0u, 0u, 0u, 0u};
    }
    for (int it = blockIdx.x * 512 + threadIdx.x; it < 32 * 208 * 16; it += gridDim.x * 512) {
        const int ch = it & 15, rr = (it >> 4) % 208, bk = it / (208 * 16);
        *(u32x4*)(Qb + ((size_t)bk * QROWS + 3 * LSEQ + rr) * 128 + ch * 8) = (u32x4){0u, 0u, 0u, 0u};
    }
}

namespace att {
constexpr int D = 128, NW = 8, QBLK = 32, KVBLK = 64, LDQ = 128, LDK = 128, NVALID = LSEQ;
constexpr float SCALE = 0.088388347648318440f, THR = 8.f;
constexpr size_t SHM_V = KVBLK * D * 2, SHM_K = KVBLK * D * 2, SHM_ATTN = 2 * SHM_V + 2 * SHM_K + NW * 64 * 4;
#define KSWZ(row, colB) ((row) * 256 + ((colB) ^ (((row) & 7) << 4)))
#define SBAR() __builtin_amdgcn_sched_barrier(0)
DEVI int crow(int r, int hi) { return (r & 3) + 8 * (r >> 2) + 4 * hi; }
DEVI void maskp(f32x16& p0, f32x16& p1, int key0, int hi) {
#pragma unroll
    for (int r = 0; r < 16; ++r) { if (key0 + crow(r, hi) >= NVALID) p0[r] = -1e30f; if (key0 + 32 + crow(r, hi) >= NVALID) p1[r] = -1e30f; }
}
DEVI void partialSM(f32x16& p0, f32x16& p1, float& m_reg, float& mn, float& alpha) {
    constexpr float C = SCALE * 1.4426950408889634f;
    float pmax = p0[0];
#pragma unroll
    for (int r = 1; r < 16; ++r) pmax = fmaxf(pmax, p0[r]);
#pragma unroll
    for (int r = 0; r < 16; ++r) pmax = fmaxf(pmax, p1[r]);
    { auto rr = __builtin_amdgcn_permlane32_swap(__float_as_uint(pmax), __float_as_uint(pmax), false, false);
      pmax = fmaxf(__uint_as_float(rr[0]), __uint_as_float(rr[1])); }
    if (__builtin_expect(__all(pmax - m_reg <= THR / SCALE), 1)) { mn = m_reg; alpha = 1.f; }
    else { mn = fmaxf(m_reg, pmax); alpha = __builtin_amdgcn_exp2f((m_reg - mn) * C); m_reg = mn; }
    const float mnC = -mn * C;
#pragma unroll
    for (int r = 0; r < 16; ++r) p0[r] = fmaf(p0[r], C, mnC);
#pragma unroll
    for (int r = 0; r < 16; ++r) p1[r] = fmaf(p1[r], C, mnC);
#pragma unroll
    for (int r = 0; r < 16; ++r) p0[r] = __builtin_amdgcn_exp2f(p0[r]);
}
DEVI void finishSM(f32x16& p0, f32x16& p1, float alpha, float& l_reg, bf16x8& pa0, bf16x8& pa1, bf16x8& pa2, bf16x8& pa3) {
#pragma unroll
    for (int r = 0; r < 16; ++r) p1[r] = __builtin_amdgcn_exp2f(p1[r]);
    float ps = 0;
#pragma unroll
    for (int r = 0; r < 16; ++r) ps += p0[r];
#pragma unroll
    for (int r = 0; r < 16; ++r) ps += p1[r];
    { auto rr = __builtin_amdgcn_permlane32_swap(__float_as_uint(ps), __float_as_uint(ps), false, false);
      ps = __uint_as_float(rr[0]) + __uint_as_float(rr[1]); }
    l_reg = l_reg * alpha + ps;
#define PK4(P, BASE, OUT) do { unsigned a0 = cvtpk(P[BASE + 0], P[BASE + 1]), a1 = cvtpk(P[BASE + 2], P[BASE + 3]);   \
    unsigned b0 = cvtpk(P[BASE + 4], P[BASE + 5]), b1 = cvtpk(P[BASE + 6], P[BASE + 7]);                              \
    auto r0 = __builtin_amdgcn_permlane32_swap(a0, b0, false, false); auto r1 = __builtin_amdgcn_permlane32_swap(a1, b1, false, false); \
    u32x4 w = {r0[0], r1[0], r0[1], r1[1]}; OUT = *reinterpret_cast<bf16x8*>(&w); } while (0)
    PK4(p0, 0, pa0); PK4(p0, 8, pa1); PK4(p1, 0, pa2); PK4(p1, 8, pa3);
#undef PK4
}
DEVI void qkt(f32x16& p0, f32x16& p1, const bf16_t* Ks, const bf16x8* qr, int r32, int hi) {
    p0 = f32x16{}; p1 = f32x16{};
#pragma unroll
    for (int d0 = 0; d0 < 8; ++d0) { const int cb = (d0 * 16 + hi * 8) * 2;
        bf16x8 b0 = *reinterpret_cast<const bf16x8*>((const char*)Ks + KSWZ(r32, cb));
        bf16x8 b1 = *reinterpret_cast<const bf16x8*>((const char*)Ks + KSWZ(32 + r32, cb));
        p0 = __builtin_amdgcn_mfma_f32_32x32x16_f16(H8(b0), H8(qr[d0]), p0, 0, 0, 0);
        p1 = __builtin_amdgcn_mfma_f32_32x32x16_f16(H8(b1), H8(qr[d0]), p1, 0, 0, 0); }
}
DEVI int v_st(int k, int c) { const int kk = (k & ~0xC) | ((k & 4) << 1) | ((k & 8) >> 1); return ((kk >> 3) * 4 + (c >> 5)) * 512 + ((kk & 7) * 32 + (c & 31)) * 2; }
DEVI int v_rd_base(int lane) { return ((lane & 3) << 3) | (((lane >> 2) & 3) << 6) | (((lane >> 4) & 1) << 5) | (((lane >> 5) & 1) << 8); }
constexpr int v_rd_off(int d0, int ks, int half) { return d0 * 512 + ks * 4096 + half * 2048; }
template <int OFF> DEVI s16x4 tr_read(int vb) { s16x4 r; asm volatile("ds_read_b64_tr_b16 %0, %1 offset:%2" : "=&v"(r) : "v"(vb), "i"(OFF) : "memory"); return r; }
template <int D0> DEVI void pv_one(f32x16& od, int vb, bf16x8 pa0, bf16x8 pa1, bf16x8 pa2, bf16x8 pa3) {
    const s16x4 l0 = tr_read<v_rd_off(D0, 0, 0)>(vb), h0 = tr_read<v_rd_off(D0, 0, 1)>(vb), l1 = tr_read<v_rd_off(D0, 1, 0)>(vb), h1 = tr_read<v_rd_off(D0, 1, 1)>(vb);
    const s16x4 l2 = tr_read<v_rd_off(D0, 2, 0)>(vb), h2 = tr_read<v_rd_off(D0, 2, 1)>(vb), l3 = tr_read<v_rd_off(D0, 3, 0)>(vb), h3 = tr_read<v_rd_off(D0, 3, 1)>(vb);
    asm volatile("s_waitcnt lgkmcnt(0)" ::: "memory"); SBAR();
#define PK(L, H) (bf16x8){L[0], L[1], L[2], L[3], H[0], H[1], H[2], H[3]}
    od = __builtin_amdgcn_mfma_f32_32x32x16_f16(H8(pa0), H8(PK(l0, h0)), od, 0, 0, 0);
    od = __builtin_amdgcn_mfma_f32_32x32x16_f16(H8(pa1), H8(PK(l1, h1)), od, 0, 0, 0);
    od = __builtin_amdgcn_mfma_f32_32x32x16_f16(H8(pa2), H8(PK(l2, h2)), od, 0, 0, 0);
    od = __builtin_amdgcn_mfma_f32_32x32x16_f16(H8(pa3), H8(PK(l3, h3)), od, 0, 0, 0);
#undef PK
}
DEVI void pv_d0(f32x16* o, int vb, bf16x8 pa0, bf16x8 pa1, bf16x8 pa2, bf16x8 pa3) {
    pv_one<0>(o[0], vb, pa0, pa1, pa2, pa3); pv_one<1>(o[1], vb, pa0, pa1, pa2, pa3); pv_one<2>(o[2], vb, pa0, pa1, pa2, pa3); pv_one<3>(o[3], vb, pa0, pa1, pa2, pa3);
}
DEVI void attn_body(const bf16_t* __restrict__ Qb, const bf16_t* __restrict__ Kh, const bf16_t* __restrict__ Vh, bf16_t* __restrict__ mixin, int b, int kv, int frow0, char* lds, bool LIGHT) {
    const int tid = threadIdx.x, wid = tid >> 6, lane = tid & 63, r32 = lane & 31, hi = lane >> 5;
    const int seq = LPAD;
    bf16_t* V_lds = (bf16_t*)lds; bf16_t* K_lds = (bf16_t*)(lds + 2 * SHM_V);
    float* ws = (float*)(lds + 2 * SHM_V + 2 * SHM_K) + wid * 64; float* li_l = ws; float* al_l = ws + 32;
    float m_reg = -1e30f, l_reg = 0; f32x16 o[4] = {}; bf16x8 qr[8];
    const bf16_t* Qw = Qb + (long)(wid * QBLK + r32) * LDQ + hi * 8;
#pragma unroll
    for (int d0 = 0; d0 < 8; ++d0) qr[d0] = *reinterpret_cast<const bf16x8*>(Qw + d0 * 16);
    const int sr = tid >> 4, sc = (tid & 15) * 8, vst0 = v_st(sr, sc), vst1 = v_st(32 + sr, sc);
    const int vb0 = (int)(uintptr_t)V_lds + v_rd_base(lane);
    constexpr int SDEPTH = 1;
    struct { bf16x8 vs0, vs1, ks0, ks1; } sr_[SDEPTH];
#define SLOAD(i, k0) do { sr_[i].vs0 = *reinterpret_cast<const bf16x8*>(&Vh[(long)((k0) + sr) * LDK + sc]); sr_[i].vs1 = *reinterpret_cast<const bf16x8*>(&Vh[(long)((k0) + 32 + sr) * LDK + sc]); \
    sr_[i].ks0 = *reinterpret_cast<const bf16x8*>(&Kh[(long)((k0) + sr) * LDK + sc]); sr_[i].ks1 = *reinterpret_cast<const bf16x8*>(&Kh[(long)((k0) + 32 + sr) * LDK + sc]); } while (0)
#define SWRITE(bb, i) do { *(bf16x8*)((char*)V_lds + (bb) * SHM_V + vst0) = sr_[i].vs0;          \
    *(bf16x8*)((char*)V_lds + (bb) * SHM_V + vst1) = sr_[i].vs1; int kc = sc * 2;               \
    *(bf16x8*)((char*)K_lds + (bb) * SHM_K + KSWZ(sr, kc)) = sr_[i].ks0;                       \
    *(bf16x8*)((char*)K_lds + (bb) * SHM_K + KSWZ(32 + sr, kc)) = sr_[i].ks1; } while (0)
#define SWAIT() do { if constexpr (SDEPTH == 2) asm volatile("s_waitcnt vmcnt(4)" ::: "memory"); else asm volatile("s_waitcnt vmcnt(0)" ::: "memory"); } while (0)
#define RESC(a) do { if (__any((a) < 1.f)) { if (hi == 0) al_l[r32] = (a); asm volatile("s_waitcnt lgkmcnt(0)" ::: "memory"); \
    _Pragma("unroll") for (int d = 0; d < 4; ++d) _Pragma("unroll") for (int r = 0; r < 16; ++r) o[d][r] *= al_l[crow(r, hi)]; } } while (0)
#define MASK(P0, P1, T) do { if (((T) + 1) * KVBLK > NVALID) maskp(P0, P1, (T) * KVBLK, hi); } while (0)
    const int NT = seq / KVBLK;
    constexpr int SE = 0, SO = SDEPTH - 1;
    static_assert(SDEPTH == 1, "the staging-only path below mirrors the SDEPTH = 1 barrier sequence");
    if (LIGHT && wid >= 2) {
        SLOAD(SE, 0); asm volatile("s_waitcnt vmcnt(0)" ::: "memory"); SWRITE(0, SE); __syncthreads();
        SLOAD(SO, KVBLK); SWAIT(); SWRITE(1, SO); __syncthreads();
        for (int j = 1; j + 1 < NT; j += 2) {
            SLOAD(SO, (j + SDEPTH) * KVBLK);
            __syncthreads(); SWAIT(); SWRITE(0, SE);
            __syncthreads();
            SLOAD(SE, (j + 1 + SDEPTH) * KVBLK);
            __syncthreads(); SWAIT(); SWRITE(1, SO);
            __syncthreads();
        }
        __syncthreads();
    } else {
    f32x16 pA0, pA1, pB0, pB1; float mnA, mnB, alA, alB; bf16x8 pa0, pa1, pa2, pa3;
    SLOAD(SE, 0); asm volatile("s_waitcnt vmcnt(0)" ::: "memory"); SWRITE(0, SE); __syncthreads();
    qkt(pA0, pA1, K_lds, qr, r32, hi); partialSM(pA0, pA1, m_reg, mnA, alA);
    SLOAD(SO, KVBLK); if constexpr (SDEPTH == 2) { if (2 < NT) SLOAD(SE, 2 * KVBLK); }
    SWAIT(); SWRITE(1, SO); __syncthreads();
    for (int j = 1; j + 1 < NT; j += 2) {
        SBAR(); qkt(pB0, pB1, (bf16_t*)((char*)K_lds + SHM_K), qr, r32, hi); MASK(pB0, pB1, j);
        finishSM(pA0, pA1, alA, l_reg, pa0, pa1, pa2, pa3); SBAR();
        SLOAD(SO, (j + SDEPTH) * KVBLK); SBAR();
        pv_d0(o, vb0, pa0, pa1, pa2, pa3); partialSM(pB0, pB1, m_reg, mnB, alB);
        __syncthreads(); SWAIT(); SWRITE(0, SE);
        RESC(alB); __syncthreads();
        SBAR(); qkt(pA0, pA1, K_lds, qr, r32, hi); MASK(pA0, pA1, j + 1);
        finishSM(pB0, pB1, alB, l_reg, pa0, pa1, pa2, pa3); SBAR();
        if (SDEPTH == 1 || j + 3 < NT) SLOAD(SE, (j + 1 + SDEPTH) * KVBLK); SBAR();
        pv_d0(o, vb0 + (int)SHM_V, pa0, pa1, pa2, pa3); partialSM(pA0, pA1, m_reg, mnA, alA);
        __syncthreads(); SWAIT(); SWRITE(1, SO);
        RESC(alA); __syncthreads();
    }
    SBAR(); qkt(pB0, pB1, (bf16_t*)((char*)K_lds + SHM_K), qr, r32, hi); MASK(pB0, pB1, NT - 1);
    finishSM(pA0, pA1, alA, l_reg, pa0, pa1, pa2, pa3); SBAR();
    pv_d0(o, vb0, pa0, pa1, pa2, pa3); partialSM(pB0, pB1, m_reg, mnB, alB);
    __syncthreads(); RESC(alB);
    finishSM(pB0, pB1, alB, l_reg, pa0, pa1, pa2, pa3); SBAR();
    pv_d0(o, vb0 + (int)SHM_V, pa0, pa1, pa2, pa3);
    if (hi == 0) li_l[r32] = l_reg; asm volatile("s_waitcnt lgkmcnt(0)" ::: "memory");
#pragma unroll
    for (int r = 0; r < 16; ++r) { const int orow = crow(r, hi); const float rl = __builtin_amdgcn_rcpf(li_l[orow]);
        const int fr = frow0 + wid * QBLK + orow;
        if (fr < 3 * LSEQ) { const int gq = fr / LSEQ, l = fr - gq * LSEQ; bf16_t* dst = mixin + (size_t)row_of(b, l) * 2048 + (kv * 3 + gq) * 128 + r32;
#pragma unroll
            for (int d0 = 0; d0 < 4; ++d0) dst[d0 * 32] = f2bf(o[d0][r] * rl); } }
    }
    __syncthreads();
#undef SLOAD
#undef SWRITE
#undef SWAIT
#undef RESC
#undef MASK
}
}

DEVI void phase_odd_prep(const Params& p, int rep) {
    const int wid = threadIdx.x >> 6, lane = threadIdx.x & 63;
    if (rep == 0) { bf16_t* RQ = (bf16_t*)(p.ws + A_RQ); bf16_t* RK = (bf16_t*)(p.ws + A_RK); const float* rl = (const float*)(p.ws + T_ROPEL);
      const int t16 = lane & 15, sub = lane >> 4;
      for (int it0 = (blockIdx.x * 8 + wid) * 4; it0 < NTOK * 16; it0 += gridDim.x * 32) {
          const int it = it0 + sub; const int r = it >> 4, hs = it & 15; int b, l; bl_of(r, b, l);
          bf16_t* v = (hs < 8 ? RQ : RK) + (size_t)r * 1024 + (hs & 7) * 128 + t16 * 8;
          const u32x4 w = *(const u32x4*)v;
          const float x[8] = {bflo(w.x), bfhi(w.x), bflo(w.y), bfhi(w.y), bflo(w.z), bfhi(w.z), bflo(w.w), bfhi(w.w)};
          const float* cs = rl + ((size_t)l * 64 + 8 * (t16 & 7)) * 2; const bool lo = t16 < 8;
          float o[8];
#pragma unroll
          for (int e = 0; e < 8; ++e) { const float xp = __shfl_xor(x[e], 8); const float c = cs[2 * e], sn = cs[2 * e + 1]; o[e] = lo ? (x[e] * c - xp * sn) : (xp * sn + x[e] * c); }
          u32x4 ow; ow.x = cvtpk(o[0], o[1]); ow.y = cvtpk(o[2], o[3]); ow.z = cvtpk(o[4], o[5]); ow.w = cvtpk(o[6], o[7]);
          *(u32x4*)v = ow; } }
    { const bf16_t* MU = (const bf16_t*)(p.ws + A_MU); bf16_t* UC = (bf16_t*)(p.ws + A_UCMU); const float* cw = p.in[23]; const float* cb = p.in[24];
      for (int it = blockIdx.x * 512 + threadIdx.x; it < NTOK * 128; it += gridDim.x * 512) {
          const int r = it >> 7, c8 = (it & 127) * 8; int b, l; bl_of(r, b, l);
          float acc[8];
#pragma unroll
          for (int e = 0; e < 8; ++e) acc[e] = cb[c8 + e];
          u32x4 self = {0u, 0u, 0u, 0u};
#pragma unroll
          for (int w = 0; w < 5; ++w) { const int ll = l + w - 2; if (ll < 0 || ll >= LSEQ) continue;
              const u32x4 x = *(const u32x4*)(MU + (size_t)row_of(b, ll) * 1024 + c8); if (w == 2) self = x;
              const f32x4 w0 = *(const f32x4*)(cw + w * 1024 + c8), w1 = *(const f32x4*)(cw + w * 1024 + c8 + 4);
              acc[0] += bflo(x.x) * w0[0]; acc[1] += bfhi(x.x) * w0[1]; acc[2] += bflo(x.y) * w0[2]; acc[3] += bfhi(x.y) * w0[3];
              acc[4] += bflo(x.z) * w1[0]; acc[5] += bfhi(x.z) * w1[1]; acc[6] += bflo(x.w) * w1[2]; acc[7] += bfhi(x.w) * w1[3]; }
#pragma unroll
          for (int e = 0; e < 8; ++e) acc[e] = acc[e] * sigmoidf_(acc[e]);
          const int h = c8 >> 7, d = c8 & 127; bf16_t* dst = UC + (size_t)r * 2048 + h * 256 + d;
          u32x4 o; o.x = cvtpk(acc[0], acc[1]); o.y = cvtpk(acc[2], acc[3]); o.z = cvtpk(acc[4], acc[5]); o.w = cvtpk(acc[6], acc[7]);
          *(u32x4*)dst = o; *(u32x4*)(dst + 128) = self; } }
    { const float* G = (const float*)(p.ws + T_GATES); const float* gb = p.in[28];
      float* GA = (float*)(p.ws + T_GA); float* GPM = (float*)(p.ws + T_GPM); float* GBT = (float*)(p.ws + T_GBT);
      for (int it = blockIdx.x * 8 + wid; it < NB * 2 * 8 * 17; it += gridDim.x * 8) {
          const int n = it % 17, h = (it / 17) & 7, dir = (it / 136) & 1, b = it / 272;
          float lf[2], li[2];
#pragma unroll
          for (int e = 0; e < 2; ++e) { const int o = lane * 2 + e, pos = dir ? 127 - o : o, l = n * 128 + pos - 112;
              if (l >= 0) { const float* gr = G + (size_t)row_of(b, l) * 32; const float gi = gr[(2 * dir) * 8 + h] + gb[(2 * dir) * 8 + h], gf = gr[(2 * dir + 1) * 8 + h] + gb[(2 * dir + 1) * 8 + h];
                  li[e] = gi; lf[e] = fminf(gf, 0.f) - log1pf(__expf(-fabsf(gf))); }
              else { li[e] = -1e4f; lf[e] = 0.f; } }
          float s1 = lf[0] + lf[1], inc = s1;
#pragma unroll
          for (int o = 1; o < 64; o <<= 1) { const float t = __shfl_up(inc, o); if (lane >= o) inc += t; }
          const float bt1 = inc, bt0 = inc - lf[1];
          const float a0 = li[0] - bt0, a1 = li[1] - bt1;
          float mx = fmaxf(a0, a1);
#pragma unroll
          for (int o = 1; o < 64; o <<= 1) { const float t = __shfl_up(mx, o); if (lane >= o) mx = fmaxf(mx, t); }
          const float mprev = __shfl_up(mx, 1); const float pm0 = lane ? fmaxf(mprev, a0) : a0, pm1 = mx;
          const size_t base = (((size_t)b * 2 + dir) * 8 + h) * LPAD + n * 128;
          const int p0 = dir ? 127 - lane * 2 : lane * 2, p1 = dir ? 126 - lane * 2 : lane * 2 + 1;
          GA[base + p0] = a0; GA[base + p1] = a1; GPM[base + p0] = pm0; GPM[base + p1] = pm1; GBT[base + p0] = bt0; GBT[base + p1] = bt1; } }
}
DEVI void phase_combine(const Params& p) {
    const int wid = threadIdx.x >> 6, lane = threadIdx.x & 63, t16 = lane & 15, sub = lane >> 4;
    bf16_t* mix = (bf16_t*)(p.ws + A_MIXIN1);
    for (int it0 = (blockIdx.x * 8 + wid) * 4; it0 < NREAL * 16; it0 += gridDim.x * 32) {
        const int it = it0 + sub; const int r = it >> 4, hs = it & 15, h = hs & 7, ml = hs >> 3;
        const size_t off = (size_t)r * 1024 + h * 128 + t16 * 8;
        const u32x4 wf = *(const u32x4*)((const bf16_t*)(p.ws + (ml ? A_T2 : A_T0)) + off), wb = *(const u32x4*)((const bf16_t*)(p.ws + (ml ? A_T3 : A_T1)) + off);
        const u32x4 gw = *(const u32x4*)((const bf16_t*)(p.ws + (ml ? A_MO : A_RG)) + off);
        float x[8] = {bflo(wf.x) + bflo(wb.x), bfhi(wf.x) + bfhi(wb.x), bflo(wf.y) + bflo(wb.y), bfhi(wf.y) + bfhi(wb.y),
                      bflo(wf.z) + bflo(wb.z), bfhi(wf.z) + bfhi(wb.z), bflo(wf.w) + bflo(wb.w), bfhi(wf.w) + bfhi(wb.w)};
        const float g[8] = {bflo(gw.x), bfhi(gw.x), bflo(gw.y), bfhi(gw.y), bflo(gw.z), bfhi(gw.z), bflo(gw.w), bfhi(gw.w)};
        float sm = 0.f;
#pragma unroll
        for (int e = 0; e < 8; ++e) sm += x[e];
        sm += __shfl_xor(sm, 8); sm += __shfl_xor(sm, 4); sm += __shfl_xor(sm, 2); sm += __shfl_xor(sm, 1);
        const float mean = sm * (1.f / 128.f); float vs = 0.f;
#pragma unroll
        for (int e = 0; e < 8; ++e) { x[e] -= mean; vs += x[e] * x[e]; }
        vs += __shfl_xor(vs, 8); vs += __shfl_xor(vs, 4); vs += __shfl_xor(vs, 2); vs += __shfl_xor(vs, 1);
        const float rs = rsqrtf(vs * (1.f / 128.f) + EPS);
        const float* gn = (ml ? p.in[29] : p.in[22]) + h * 128 + t16 * 8; const f32x4 n0 = *(const f32x4*)gn, n1 = *(const f32x4*)(gn + 4);
        float o[8];
#pragma unroll
        for (int e = 0; e < 8; ++e) { const float sg = sigmoidf_(g[e]); const float tt = ml ? sg : g[e] * sg; o[e] = x[e] * rs * (e < 4 ? n0[e] : n1[e - 4]) * tt; }
        u32x4 ow; ow.x = cvtpk(o[0], o[1]); ow.y = cvtpk(o[2], o[3]); ow.z = cvtpk(o[4], o[5]); ow.w = cvtpk(o[6], o[7]);
        *(u32x4*)(mix + (size_t)r * 2048 + ml * 1024 + h * 128 + t16 * 8) = ow;
    }
}

namespace ch {
DEVI unsigned offb(unsigned row, unsigned c16) { return 256u * row + 16u * (c16 ^ (((row & 3u) << 2) | ((row >> 2) & 3u))); }
DEVI s16x4 trr(unsigned addr) { s16x4 r; asm volatile("ds_read_b64_tr_b16 %0, %1" : "=&v"(r) : "v"(addr) : "memory"); return r; }
#define LWAIT() do { asm volatile("s_waitcnt lgkmcnt(0)" ::: "memory"); __builtin_amdgcn_sched_barrier(0); } while (0)
#define PK8(L, H) (bf16x8){L[0], L[1], L[2], L[3], H[0], H[1], H[2], H[3]}
DEVI int crow(int r, int hi) { return (r & 3) + 8 * (r >> 2) + 4 * hi; }
struct TrL { unsigned hi, blk, q, p; DEVI void init(int lane) { hi = lane >> 5; blk = (lane >> 4) & 1; q = (lane & 15) >> 2; p = lane & 3; } };
DEVI unsigned tra_nat(const TrL& t, unsigned img, int k0, int c, int tt) { return img + offb(k0 + 8 * t.hi + 4 * tt + t.q, 4 * c + 2 * t.blk + (t.p >> 1)) + 8 * (t.p & 1); }
DEVI unsigned tra_perm(const TrL& t, unsigned img, int k0, int c, int tt) { return img + offb(k0 + 8 * tt + 4 * t.hi + t.q, 4 * c + 2 * t.blk + (t.p >> 1)) + 8 * (t.p & 1); }
DEVI u32x4 scale8(u32x4 w, float s) { u32x4 o; o.x = cvtpk(bflo(w.x) * s, bfhi(w.x) * s); o.y = cvtpk(bflo(w.y) * s, bfhi(w.y) * s); o.z = cvtpk(bflo(w.z) * s, bfhi(w.z) * s); o.w = cvtpk(bflo(w.w) * s, bfhi(w.w) * s); return o; }

template <bool SC, int UNR, class F> DEVI void stage_tile(char* img, const bf16_t* base, int ld, int b, int n, const F& rs) {
#pragma unroll UNR
    for (int it = 0; it < 4; ++it) { const int idx = threadIdx.x + 512 * it, row = idx >> 4, c16 = idx & 15, l = n * 128 + row - 112;
        u32x4 w = {0u, 0u, 0u, 0u};
        if (l >= 0) { w = *(const u32x4*)(base + (size_t)row_of(b, l) * ld + c16 * 8); if (SC) w = scale8(w, rs(row)); }
        *(u32x4*)(img + offb(row, c16)) = w; }
}
template <bool SC> DEVI void load_q(bf16x8 (&qf)[8], const bf16_t* base, int ld, int b, int lq, int hi, float s) {
#pragma unroll
    for (int ks = 0; ks < 8; ++ks) { u32x4 w = {0u, 0u, 0u, 0u};
        if (lq >= 0) { w = *(const u32x4*)(base + (size_t)row_of(b, lq) * ld + ks * 16 + hi * 8); if (SC) w = scale8(w, s); }
        qf[ks] = *reinterpret_cast<bf16x8*>(&w); }
}
DEVI void scoresT(f32x16 (&p)[4], const char* Kimg, const bf16x8 (&qf)[8], int r32, int hi) {
#pragma unroll
    for (int kt = 0; kt < 4; ++kt) { p[kt] = f32x16{};
#pragma unroll
        for (int ks = 0; ks < 8; ++ks) { const bf16x8 a = *(const bf16x8*)(Kimg + offb(32 * kt + r32, 2 * ks + hi)); p[kt] = __builtin_amdgcn_mfma_f32_32x32x16_f16(H8(a), H8(qf[ks]), p[kt], 0, 0, 0); } }
}
DEVI f32x16 scoresT1(int kt, const char* Kimg, const bf16x8 (&qf)[8], int r32, int hi) {
    f32x16 p = {};
#pragma unroll
    for (int ks = 0; ks < 8; ++ks) { const bf16x8 a = *(const bf16x8*)(Kimg + offb(32 * kt + r32, 2 * ks + hi)); p = __builtin_amdgcn_mfma_f32_32x32x16_f16(H8(a), H8(qf[ks]), p, 0, 0, 0); }
    return p;
}
DEVI void packP1(bf16x8& p0, bf16x8& p1, const f32x16& p) {
    u32x4 w; w.x = cvtpk(p[0], p[1]); w.y = cvtpk(p[2], p[3]); w.z = cvtpk(p[4], p[5]); w.w = cvtpk(p[6], p[7]); p0 = *reinterpret_cast<bf16x8*>(&w);
    u32x4 v; v.x = cvtpk(p[8], p[9]); v.y = cvtpk(p[10], p[11]); v.z = cvtpk(p[12], p[13]); v.w = cvtpk(p[14], p[15]); p1 = *reinterpret_cast<bf16x8*>(&v);
}
DEVI void packP(bf16x8 (&pb)[8], const f32x16 (&p)[4]) {
#pragma unroll
    for (int kt = 0; kt < 4; ++kt)
#pragma unroll
        for (int ss = 0; ss < 2; ++ss) { u32x4 w; w.x = cvtpk(p[kt][8 * ss], p[kt][8 * ss + 1]); w.y = cvtpk(p[kt][8 * ss + 2], p[kt][8 * ss + 3]);
            w.z = cvtpk(p[kt][8 * ss + 4], p[kt][8 * ss + 5]); w.w = cvtpk(p[kt][8 * ss + 6], p[kt][8 * ss + 7]); pb[kt * 2 + ss] = *reinterpret_cast<bf16x8*>(&w); }
}
DEVI void inter_acc(f32x16& o, const char* Rt, int c, const bf16x8 (&qf)[8], int r32, int hi) {
#pragma unroll
    for (int ks = 0; ks < 8; ++ks) { const bf16x8 a = *(const bf16x8*)(Rt + offb(32 * c + r32, 2 * ks + hi)); o = __builtin_amdgcn_mfma_f32_32x32x16_f16(H8(a), H8(qf[ks]), o, 0, 0, 0); }
}
DEVI void intra_acc(f32x16& o, unsigned Vimg, int c, const bf16x8 (&pb)[8], const TrL& t) {
#pragma unroll
    for (int half = 0; half < 2; ++half) {
        s16x4 lo[4], hh[4];
#pragma unroll
        for (int k = 0; k < 4; ++k) { const int kk = half * 4 + k; lo[k] = trr(tra_perm(t, Vimg, 16 * kk, c, 0)); hh[k] = trr(tra_perm(t, Vimg, 16 * kk, c, 1)); }
        LWAIT();
#pragma unroll
        for (int k = 0; k < 4; ++k) o = __builtin_amdgcn_mfma_f32_32x32x16_f16(H8(PK8(lo[k], hh[k])), H8(pb[half * 4 + k]), o, 0, 0, 0);
    }
}
DEVI void state_acc(f32x16& acc, unsigned Kimg, unsigned Vimg, int qb, int c, const TrL& t) {
#pragma unroll
    for (int half = 0; half < 2; ++half) {
        s16x4 al[4], ah[4], bl[4], bh[4];
#pragma unroll
        for (int k = 0; k < 4; ++k) { const int ks = half * 4 + k; al[k] = trr(tra_nat(t, Kimg, 16 * ks, qb, 0)); ah[k] = trr(tra_nat(t, Kimg, 16 * ks, qb, 1));
            bl[k] = trr(tra_nat(t, Vimg, 16 * ks, c, 0)); bh[k] = trr(tra_nat(t, Vimg, 16 * ks, c, 1)); }
        LWAIT();
#pragma unroll
        for (int k = 0; k < 4; ++k) acc = __builtin_amdgcn_mfma_f32_32x32x16_f16(H8(PK8(al[k], ah[k])), H8(PK8(bl[k], bh[k])), acc, 0, 0, 0);
    }
}
DEVI void state_acc_w(f32x16& acc, unsigned Kimg, unsigned Vimg, const bf16_t* wtab, int qb, int c, const TrL& t) {
#pragma unroll
    for (int half = 0; half < 2; ++half) {
        s16x4 al[4], ah[4], bl[4], bh[4];
#pragma unroll
        for (int k = 0; k < 4; ++k) { const int ks = half * 4 + k; al[k] = trr(tra_nat(t, Kimg, 16 * ks, qb, 0)); ah[k] = trr(tra_nat(t, Kimg, 16 * ks, qb, 1));
            bl[k] = trr(tra_nat(t, Vimg, 16 * ks, c, 0)); bh[k] = trr(tra_nat(t, Vimg, 16 * ks, c, 1)); }
        LWAIT();
#pragma unroll
        for (int k = 0; k < 4; ++k) { const f16x8 wf = *(const f16x8*)(wtab + 16 * (half * 4 + k) + 8 * t.hi);
            const f16x8 bv = H8(PK8(bl[k], bh[k])) * wf;
            acc = __builtin_amdgcn_mfma_f32_32x32x16_f16(H8(PK8(al[k], ah[k])), bv, acc, 0, 0, 0); }
    }
}
DEVI void write_Rt(char* Rt, const f32x16& acc, int qb, int c, int r32, int hi) {
#pragma unroll
    for (int rg = 0; rg < 4; ++rg) { u32x2 w; w.x = cvtpk(acc[4 * rg], acc[4 * rg + 1]); w.y = cvtpk(acc[4 * rg + 2], acc[4 * rg + 3]);
        *(u32x2*)(Rt + offb(32 * c + r32, 4 * qb + rg) + 8 * hi) = w; }
}
DEVI void store_o(bf16_t* dst  , const f32x16& o, int c, int hi, float s) {
#pragma unroll
    for (int rg = 0; rg < 4; ++rg) { u32x2 w; w.x = cvtpk(o[4 * rg] * s, o[4 * rg + 1] * s); w.y = cvtpk(o[4 * rg + 2] * s, o[4 * rg + 3] * s);
        *(u32x2*)(dst + 32 * c + 8 * rg + 4 * hi) = w; }
}

DEVI void retention_chain(const Params& p, int b, int h, int dir, char* lds) {
    int tid = threadIdx.x; asm volatile("" : "+v"(tid)); const int wid = __builtin_amdgcn_readfirstlane(tid >> 6), lane = tid & 63, qb = wid & 3, eh = wid >> 2; int r32 = lane & 31, hi = lane >> 5;
    TrL t; t.init(lane);
    char* Kimg = lds; char* Vimg = lds + 32768; char* Rt = lds + 65536;
    const unsigned Ka = (unsigned)(uintptr_t)Kimg, Va = (unsigned)(uintptr_t)Vimg;
    const bf16_t* RQ = (const bf16_t*)(p.ws + A_RQ) + h * 128; const bf16_t* RK = (const bf16_t*)(p.ws + A_RK) + h * 128; const bf16_t* RV = (const bf16_t*)(p.ws + A_RV) + h * 128;
    bf16_t* T = (bf16_t*)(p.ws + (dir ? A_T1 : A_T0)) + h * 128;
    const float lg2 = -fabsf(p.in[21][dir * 8 + h]) * 1.4426950408889634f;
    const float g128 = __builtin_amdgcn_exp2f(128.f * lg2);
    for (int i = tid; i < 2048; i += 512) *(u32x4*)(Rt + i * 16) = (u32x4){0u, 0u, 0u, 0u};
    f32x16 racc[2] = {};
    int q = 32 * qb + r32;
    const float qs = 0.088388347648318440f * __builtin_amdgcn_exp2f(lg2 * (dir ? -(float)q : (float)(q - 127)));
    __syncthreads();
#pragma unroll 1
    for (int st = 0; st < 17; ++st) { const int n = dir ? 16 - st : st;
        asm volatile("" : "+v"(r32), "+v"(hi), "+v"(t.hi), "+v"(t.blk), "+v"(t.q), "+v"(t.p), "+v"(q));
        stage_tile<true, 4>(Kimg, RK, 1024, b, n, [&](int row) { return __builtin_amdgcn_exp2f(lg2 * (dir ? (float)row : (float)(127 - row))); });
        stage_tile<false, 4>(Vimg, RV, 1024, b, n, [&](int) { return 1.f; });
        const int lq = n * 128 + q - 112;
        bf16x8 qf[8]; load_q<true>(qf, RQ, 1024, b, lq, hi, qs);
        __syncthreads();
        bf16x8 pb[8];
#pragma unroll
        for (int kt = 0; kt < 4; ++kt) { f32x16 pt = scoresT1(kt, Kimg, qf, r32, hi);
#pragma unroll
            for (int r = 0; r < 16; ++r) { const int s = 32 * kt + crow(r, hi); const bool keep = dir ? (s > q) : (s <= q); if (!keep) pt[r] = 0.f; }
            packP1(pb[2 * kt], pb[2 * kt + 1], pt); }
#pragma unroll
        for (int x = 0; x < 2; ++x) { const int c = 2 * eh + x; f32x16 o = {};
            inter_acc(o, Rt, c, qf, r32, hi); intra_acc(o, Va, c, pb, t);
            if (lq >= 0) store_o(T + (size_t)row_of(b, lq) * 1024, o, c, hi, 1.f); }
        __syncthreads();
#pragma unroll
        for (int x = 0; x < 2; ++x) { const int c = 2 * eh + x; state_acc(racc[x], Ka, Va, qb, c, t);
#pragma unroll
            for (int r = 0; r < 16; ++r) racc[x][r] *= g128;
            write_Rt(Rt, racc[x], qb, c, r32, hi); }
        __syncthreads();
    }
}

#ifndef MLU
#define MLU 4
#endif
DEVI void mlstm_chain(const Params& p, int b, int h, int dir, char* lds) {
    int tid = threadIdx.x; asm volatile("" : "+v"(tid)); const int wid = __builtin_amdgcn_readfirstlane(tid >> 6), lane = tid & 63, qb = wid & 3, eh = wid >> 2; int r32 = lane & 31, hi = lane >> 5;
    TrL t; t.init(lane);
    char* Kimg = lds; char* Vimg = lds + 32768; char* Ct = lds + 65536; char* Khat = lds + 98304; char* Nimg = lds + 131072;
    float* ta = (float*)(lds + 139264); float* tpm = ta + 128; float* tbt = ta + 256; float* tn = ta + 384; bf16_t* wtab = (bf16_t*)(lds + 98304);
    const unsigned Va = (unsigned)(uintptr_t)Vimg, Ka = (unsigned)(uintptr_t)Kimg;
    const bf16_t* MQ = (const bf16_t*)(p.ws + A_MQKV) + h * 384; const bf16_t* MK = MQ + 128; const bf16_t* MV = MQ + 256;
    bf16_t* T = (bf16_t*)(p.ws + (dir ? A_T3 : A_T2)) + h * 128;
    const size_t gbase = (((size_t)b * 2 + dir) * 8 + h) * LPAD;
    const float* GA = (const float*)(p.ws + T_GA) + gbase; const float* GPM = (const float*)(p.ws + T_GPM) + gbase; const float* GBT = (const float*)(p.ws + T_GBT) + gbase;
    for (int i = tid; i < 2048 + 512; i += 512) *(u32x4*)(Ct + (i < 2048 ? i * 16 : 65536 + (i - 2048) * 16)) = (u32x4){0u, 0u, 0u, 0u};
    f32x16 cacc[2] = {};
    if (tid < 128) tn[tid] = 0.f;
    float m_prev = 0.f;
    int q = 32 * qb + r32;
    __syncthreads();
#pragma unroll 1
    for (int st = 0; st < 17; ++st) { const int n = dir ? 16 - st : st;
        asm volatile("" : "+v"(r32), "+v"(hi), "+v"(t.hi), "+v"(t.blk), "+v"(t.q), "+v"(t.p), "+v"(q));
        const int pe = n * 128 + (dir ? 0 : 127);
        const float amax = GPM[pe], btT = GBT[pe];
        const float m_loc = amax + btT, m_new = fmaxf(btT + m_prev, m_loc), f_prev = __expf(btT + m_prev - m_new), f_loc = __expf(m_loc - m_new);
        stage_tile<false, MLU>(Kimg, MK, 3072, b, n, [&](int) { return 1.f; });
        stage_tile<false, MLU>(Vimg, MV, 3072, b, n, [&](int) { return 1.f; });
        if (tid < 128) { const float av = GA[n * 128 + tid]; ta[tid] = av; tpm[tid] = GPM[n * 128 + tid]; tbt[tid] = GBT[n * 128 + tid]; wtab[tid] = f2bf(__expf(av - amax) * f_loc); }
        const int lq = n * 128 + q - 112;
        bf16x8 qf[8]; load_q<false>(qf, MQ, 3072, b, lq, hi, 1.f);
        __syncthreads();
        const float Mq = fmaxf(m_prev, tpm[q]), w_inter = __expf(m_prev - Mq), m_t = tbt[q] + Mq;
        f32x16 qn = {};
#pragma unroll
        for (int ks = 0; ks < 8; ++ks) { const bf16x8 a = *(const bf16x8*)(Nimg + offb(r32, 2 * ks + hi)); qn = __builtin_amdgcn_mfma_f32_32x32x16_f16(H8(a), H8(qf[ks]), qn, 0, 0, 0); }
        float qns = 0.f;
#pragma unroll
        for (int r = 0; r < 16; ++r) qns += qn[r];
        { auto rr = __builtin_amdgcn_permlane32_swap(__float_as_uint(qns), __float_as_uint(qns), false, false); qns = __uint_as_float(rr[0]) + __uint_as_float(rr[1]); }
        float ds = 0.f; bf16x8 pb[8];
#pragma unroll
        for (int kt = 0; kt < 4; ++kt) { f32x16 pt = scoresT1(kt, Kimg, qf, r32, hi);
#pragma unroll
            for (int rg = 0; rg < 4; ++rg) { const int s0 = 32 * kt + 8 * rg + 4 * hi; const f32x4 av = *(const f32x4*)(ta + s0);
#pragma unroll
                for (int e = 0; e < 4; ++e) { const int s = s0 + e; const bool keep = dir ? (s >= q) : (s <= q);
                    const float w = keep ? __expf(av[e] - Mq) : 0.f; const float v = pt[4 * rg + e] * w; pt[4 * rg + e] = v; ds += v; } }
            packP1(pb[2 * kt], pb[2 * kt + 1], pt); }
        { auto rr = __builtin_amdgcn_permlane32_swap(__float_as_uint(ds), __float_as_uint(ds), false, false); ds = __uint_as_float(rr[0]) + __uint_as_float(rr[1]); }
        const float den = ds + w_inter * qns;
        const float inv = 1.f / fmaxf(fabsf(den), __expf(-m_t));
#pragma unroll
        for (int x = 0; x < 2; ++x) { const int c = 2 * eh + x; f32x16 o = {};
            inter_acc(o, Ct, c, qf, r32, hi);
#pragma unroll
            for (int r = 0; r < 16; ++r) o[r] *= w_inter;
            intra_acc(o, Va, c, pb, t);
            if (lq >= 0) store_o(T + (size_t)row_of(b, lq) * 1024, o, c, hi, inv); }
        __syncthreads();
#pragma unroll
        for (int x = 0; x < 2; ++x) { const int c = 2 * eh + x;
#pragma unroll
            for (int r = 0; r < 16; ++r) cacc[x][r] *= f_prev;
            state_acc_w(cacc[x], Ka, Va, wtab, qb, c, t); write_Rt(Ct, cacc[x], qb, c, r32, hi); }
        if (eh == 0) {
            f32x16 nacc = {};
#pragma unroll
            for (int half = 0; half < 2; ++half) { s16x4 al[4], ah[4];
#pragma unroll
                for (int k = 0; k < 4; ++k) { const int ks = half * 4 + k; al[k] = trr(tra_nat(t, Ka, 16 * ks, qb, 0)); ah[k] = trr(tra_nat(t, Ka, 16 * ks, qb, 1)); }
                LWAIT();
#pragma unroll
                for (int k = 0; k < 4; ++k) { const f16x8 wf = *(const f16x8*)(wtab + 16 * (half * 4 + k) + 8 * t.hi); nacc = __builtin_amdgcn_mfma_f32_32x32x16_f16(H8(PK8(al[k], ah[k])), wf, nacc, 0, 0, 0); } }
            if (r32 == 0) {
#pragma unroll
                for (int rg = 0; rg < 4; ++rg) { float* np = tn + 32 * qb + 8 * rg + 4 * hi; f32x4 nv = *(f32x4*)np;
#pragma unroll
                    for (int e = 0; e < 4; ++e) nv[e] = nv[e] * f_prev + nacc[4 * rg + e];
                    *(f32x4*)np = nv; u32x2 w; w.x = cvtpk(nv[0], nv[1]); w.y = cvtpk(nv[2], nv[3]);
                    *(u32x2*)(Nimg + offb(0, 4 * qb + rg) + 8 * hi) = w; } }
        }
        m_prev = m_new;
        __syncthreads();
    }
}
}

#define XB_TMO      128
#define XB_XCNT(j)  (256  + 64 * (j))
#define XB_XSUB(j)  (1280 + 64 * (j))
#define XB_XGEN(j)  (2304 + 64 * (j))
#define XB_TOP      3328
#define XB_TOPGEN   3392
#define XCD_BAR_WORDS 3456
#define XB_SPIN_CAP (1u << 18)
DEVI unsigned xb_ld(unsigned* p)              { return __hip_atomic_load(p, __ATOMIC_RELAXED, __HIP_MEMORY_SCOPE_AGENT); }
DEVI unsigned xb_add(unsigned* p, unsigned v) { return __hip_atomic_fetch_add(p, v, __ATOMIC_RELAXED, __HIP_MEMORY_SCOPE_AGENT); }
DEVI unsigned xb_xcc_id() { return (unsigned)__builtin_amdgcn_s_getreg((3 << 11) | 20) & 0xFu; }
#define XB_SPIN(cond, bar) do { unsigned _sp = 0; while (cond) { __builtin_amdgcn_s_sleep(1); \
    if ((++_sp & 255u) == 0u) { if (xb_ld(&(bar)[XB_TMO])) break; if (_sp > XB_SPIN_CAP) { atomicAdd(&(bar)[XB_TMO], 1u); break; } } } } while (0)
struct XcdBarrier { unsigned* bar; unsigned x; volatile LAS unsigned* st; };
DEVI XcdBarrier xcd_barrier_post(unsigned* bar, volatile LAS unsigned* st) {
    XcdBarrier b; b.bar = bar; b.x = xb_xcc_id(); b.st = st;
    if (threadIdx.x == 0) (void)xb_add(&bar[XB_XCNT(b.x)], 1u);
    return b;
}
DEVI void xcd_barrier_complete(unsigned* bar, unsigned x, unsigned& nloc, unsigned& nx) {
    const unsigned G = gridDim.x * gridDim.y * gridDim.z;
    unsigned sum, cnt, mine, sp = 0u;
    for (;;) {
        sum = 0u; cnt = 0u; mine = 0u;
#pragma unroll
        for (unsigned j = 0; j < 16; ++j) { const unsigned c = xb_ld(&bar[XB_XCNT(j)]); sum += c; cnt += (c > 0u) ? 1u : 0u; mine = (j == x) ? c : mine; }
        if (sum == G) break;
        __builtin_amdgcn_s_sleep(1);
        if ((++sp & 255u) == 0u) { if (xb_ld(&bar[XB_TMO])) break; if (sp > XB_SPIN_CAP) { atomicAdd(&bar[XB_TMO], 1u); break; } }
    }
    nloc = mine > 0u ? mine : 1u; nx = cnt > 0u ? cnt : 1u;
}
DEVI void xcd_barrier(const XcdBarrier& b) {
    asm volatile("s_waitcnt vmcnt(0)" ::: "memory");
    __syncthreads();
    if (threadIdx.x == 0) {
        unsigned* bar = b.bar;
        __builtin_amdgcn_s_waitcnt(0);
        unsigned nloc = b.st[0], nx = b.st[1];
        if (nloc == 0u) { xcd_barrier_complete(bar, b.x, nloc, nx); b.st[0] = nloc; b.st[1] = nx; }
        const unsigned old = xb_add(&bar[XB_XSUB(b.x)], 1u);
        const unsigned gen = old / nloc;
        if (old + 1u == (gen + 1u) * nloc) {
            __builtin_amdgcn_fence(__ATOMIC_RELEASE, "agent");
            asm volatile("s_waitcnt vmcnt(0)" ::: "memory");
            const unsigned og = xb_add(&bar[XB_TOP], 1u);
            const unsigned tg = og / nx;
            if (og + 1u == (tg + 1u) * nx) xb_add(&bar[XB_TOPGEN], 1u);
            else XB_SPIN(xb_ld(&bar[XB_TOPGEN]) == tg, bar);
            __builtin_amdgcn_fence(__ATOMIC_ACQUIRE, "agent");
            xb_add(&bar[XB_XGEN(b.x)], 1u);
            asm volatile("s_waitcnt vmcnt(0)" ::: "memory");
        } else {
            XB_SPIN(xb_ld(&bar[XB_XGEN(b.x)]) == gen, bar);
            __builtin_amdgcn_fence(__ATOMIC_ACQUIRE, "agent");
            asm volatile("s_waitcnt vmcnt(0)" ::: "memory");
        }
    }
    __syncthreads();
}

constexpr int LDS_BYTES = 141312 + 16;
constexpr int NPHASE = 21;
#ifndef PH_MASK
#define PH_MASK 0xFFFFFFFFu
#endif
#define PHON(n) (((PH_MASK) >> (n)) & 1u)
#ifndef REP_MASK
#define REP_MASK 0u
#endif

DEVI void mlw_fill(const Params& p) {
    bf16_t* W = (bf16_t*)(p.ws + W_MLW);
    for (int i = blockIdx.x * 512 + threadIdx.x; i < 8 * 512 * 256; i += gridDim.x * 512) {
        const int k = i & 255, n = (i >> 8) & 511, h = i >> 17; float v = 0.f;
        if (n < 128) { if (k < 128) v = p.in[25][((size_t)h * 128 + k) * 128 + n]; }
        else if (n < 256) { if (k < 128) v = p.in[26][((size_t)h * 128 + k) * 128 + (n - 128)] * 0.088388347648318440f; }
        else if (n < 384) { if (k >= 128) v = p.in[27][((size_t)h * 128 + (k - 128)) * 128 + (n - 256)]; }
        W[i] = f2bf(v);
    }
}

template <int PH> DEVI void phase_body(const Params& p, LAS unsigned char* lds, unsigned char* shm, int rep = 0) {
    unsigned char* ws = p.ws;
    bf16_t* X = (bf16_t*)(ws + A_X);
    const int G = gridDim.x;
    switch (PH) {
        case 0: if constexpr (PHON(0) && PH == 0) {
            phase_tables(p);
            tcvt_job(p.in[5], 2048, 3072, (bf16_t*)(ws + W_WINT), 2048, (float*)shm);
            tcvt_job(p.in[6], 2048, 2048, (bf16_t*)(ws + W_WOUT0), 2048, (float*)shm);
            tcvt_job(p.in[17], 512, 512, (bf16_t*)(ws + W_GLUT), 512, (float*)shm);
            phase_init_h(p, p.in[2]);
        } break;
        case 1: if constexpr (PHON(1) && PH == 1) {
            phase_s5_build(p);
            __syncthreads();
            pg8::Gemm g{X, (const bf16_t*)(ws + W_WINT), 2048, 2048, 2048, 65, 12, 1, 0, 0};
            pg8::EpiWin0 E{(bf16_t*)(ws + A_PROJ0), (bf16_t*)(ws + A_A2)};
            pg8::gemm_phase(lds, g, E);
        } break;
        case 2: if constexpr (PHON(2) && PH == 2) {
            phase_s5_build2(p);
            pg8::Gemm g{(const bf16_t*)(ws + A_A2), (const bf16_t*)(ws + W_S5E), 512, 256, 256, 5, 1, 32, (size_t)1280 * 512, (size_t)256 * 256};
            pg8::EpiF32 E{(float*)(ws + A_S), 256, (size_t)1280 * 256};
            pg8::gemm_phase(lds, g, E);
            __syncthreads();
            phase_qk(p);
        } break;
        case 3: if constexpr (PHON(3) && PH == 3) {
            phase_s5_scan(p);
            __syncthreads();
#ifndef ATT_REP
#define ATT_REP 1
#endif
            int natt = NB * 4 * 25 * ATT_REP; if (ATT_REP > 1) asm volatile("" : "+s"(natt));
            for (int it0 = blockIdx.x; it0 < natt; it0 += G) {
                const int it = it0 % (NB * 4 * 25);
                const bool light = it >= 768; const int bk = light ? it - 768 : it / 24, qb = light ? 24 : it % 24, b = bk >> 2, kv = bk & 3;
                const bf16_t* qp = (const bf16_t*)(ws + A_QB) + ((size_t)bk * QROWS + qb * 256) * 128; const bf16_t* kp = (const bf16_t*)(ws + A_KB) + (size_t)bk * LPAD * 128; const bf16_t* vp = (const bf16_t*)(ws + A_VB) + (size_t)bk * LPAD * 128;
                att::attn_body(qp, kp, vp, (bf16_t*)(ws + A_MIXIN0), b, kv, qb * 256, (char*)shm, light);
            }
            if (rep == 0) {
                tcvt_job(p.in[3], 2048, 8192, (bf16_t*)(ws + W_W1T), 2048, (float*)shm);
                tcvt_job(p.in[4], 8192, 2048, (bf16_t*)(ws + W_W2T), 8192, (float*)shm);
            }
        } break;
        case 4: if constexpr (PHON(4) && PH == 4) {
            pg8::Gemm g{(const bf16_t*)(ws + A_A2), (const bf16_t*)(ws + W_S5WY), 512, 512, 512, 5, 1, 32, (size_t)1280 * 512, (size_t)256 * 512};
            pg8::EpiS5Y E{(bf16_t*)(ws + A_YS)};
            pg8::gemm_phase(lds, g, E);
        } break;
        case 5: if constexpr (PHON(5) && PH == 5) {
            pg8::Gemm g{(const bf16_t*)(ws + A_YS), (const bf16_t*)(ws + W_GLUT), 512, 512, 512, 65, 2, 1, 0, 0};
            pg8::EpiGlu E{(const bf16_t*)(ws + A_YS), p.in[18], (bf16_t*)(ws + A_MIXIN0)};
            pg8::gemm_phase(lds, g, E);
        } break;
        case 6: if constexpr (PHON(6) && PH == 6) {
            pg8::Gemm g{(const bf16_t*)(ws + A_MIXIN0), (const bf16_t*)(ws + W_WOUT0), 2048, 2048, 2048, 64, 8, 1, 0, 0};
            pg8::EpiBf16<0> E{X, 2048};
            pg8::gemm_phase(lds, g, E);
            pg8::Gemm gt{(const bf16_t*)(ws + A_MIXIN0) + (size_t)NREAL * 2048, (const bf16_t*)(ws + W_WOUT0), 2048, 2048, 256, 1, 8, 8, 256, 256};
            pg8::EpiPart Et{(float*)(ws + A_PT)};
            pg8::gemm_phase(lds, gt, Et);
        } break;
        case 7: if constexpr (PHON(7) && PH == 7) { phase_norm<0>(p, NTOK, p.in[2] + 1 * DM, p.in[2] + 2 * DM, (const float*)(p.ws + A_PT), 8, rep ? 0.f : 1.f, rep ? nullptr : p.in[0]); } break;
        case 8: if constexpr (PHON(8) && PH == 8) {
            pg8::Gemm g{X, (const bf16_t*)(ws + W_W1T), 2048, 2048, 2048, 65, 32, 1, 0, 0};
            pg8::EpiBf16<1> E{(bf16_t*)(ws + A_MID), 8192};
            pg8::gemm_phase(lds, g, E);
        } break;
        case 9: if constexpr (PHON(9) && PH == 9) {
            pg8::Gemm g{(const bf16_t*)(ws + A_MID), (const bf16_t*)(ws + W_W2T), 8192, 8192, 8192, 64, 8, 1, 0, 0};
            pg8::EpiBf16<0> E{X, 2048};
            pg8::gemm_phase(lds, g, E);
            pg8::Gemm gt{(const bf16_t*)(ws + A_MID) + (size_t)NREAL * 8192, (const bf16_t*)(ws + W_W2T), 8192, 8192, 512, 1, 8, 16, 512, 512};
            pg8::EpiPart Et{(float*)(ws + A_PT)};
            pg8::gemm_phase(lds, gt, Et);
        } break;
        case 10: if constexpr (PHON(10) && PH == 10) {
            phase_norm<0>(p, NTOK, p.in[2] + 3 * DM, p.in[2] + 4 * DM, (const float*)(p.ws + A_PT), 16, rep ? 0.f : 1.f);
            tcvt_job(p.in[19], 2048, 6176, (bf16_t*)(ws + W_WINT), 2048, (float*)shm);
            tcvt_job(p.in[20], 2048, 2048, (bf16_t*)(ws + W_WOUT1), 2048, (float*)shm);
            for (int i = blockIdx.x * 512 + threadIdx.x; i < 224 * 256; i += G * 512) *(u32x4*)(ws + W_WINT + (size_t)6176 * 4096 + (size_t)i * 16) = (u32x4){0u, 0u, 0u, 0u};
            mlw_fill(p);
        } break;
        case 11: if constexpr (PHON(11) && PH == 11) {
            pg8::Gemm g{X, (const bf16_t*)(ws + W_WINT), 2048, 2048, 2048, 65, 25, 1, 0, 0};
            pg8::EpiWin1 E{(bf16_t*)(ws + A_RQ), (float*)(ws + T_GATES)};
            pg8::gemm_phase(lds, g, E);
            if (blockIdx.x >= 89 && rep == 0) {
                tcvt_job(p.in[3] + (size_t)2048 * 8192, 2048, 8192, (bf16_t*)(ws + W_W1T), 2048, (float*)shm, (int)blockIdx.x - 89, G - 89);
                tcvt_job(p.in[4] + (size_t)2048 * 8192, 8192, 2048, (bf16_t*)(ws + W_W2T), 8192, (float*)shm, (int)blockIdx.x - 89, G - 89);
            }
        } break;
        case 12: if constexpr (PHON(12) && PH == 12) { phase_odd_prep(p, rep); } break;
        case 13: if constexpr (PHON(13) && PH == 13) {
            pg8::Gemm g{(const bf16_t*)(ws + A_UCMU), (const bf16_t*)(ws + W_MLW), 2048, 256, 256, 65, 2, 8, 256, (size_t)512 * 256};
            pg8::EpiMqkv E{(bf16_t*)(ws + A_MQKV)};
            pg8::gemm_phase(lds, g, E);
        } break;
        case 14: if constexpr (PHON(14) && PH == 14) {
            for (int it = blockIdx.x; it < 256; it += G) {
                const int kind = it & 1, j = it >> 1, dir = j & 1, h = (j >> 1) & 7, b = j >> 4;
                if (kind == 0) ch::retention_chain(p, b, h, dir, (char*)shm); else ch::mlstm_chain(p, b, h, dir, (char*)shm);
                __syncthreads();
            }
        } break;
        case 15: if constexpr (PHON(15) && PH == 15) { phase_combine(p); } break;
        case 16: if constexpr (PHON(16) && PH == 16) {
            pg8::Gemm g{(const bf16_t*)(ws + A_MIXIN1), (const bf16_t*)(ws + W_WOUT1), 2048, 2048, 2048, 64, 8, 1, 0, 0};
            pg8::EpiBf16<0> E{X, 2048};
            pg8::gemm_phase(lds, g, E);
        } break;
        case 17: if constexpr (PHON(17) && PH == 17) { phase_norm<0>(p, NREAL, p.in[2] + 5 * DM, p.in[2] + 6 * DM, nullptr, 0, rep ? 0.f : 1.f); } break;
        case 18: if constexpr (PHON(18) && PH == 18) {
            pg8::Gemm g{X, (const bf16_t*)(ws + W_W1T), 2048, 2048, 2048, 64, 32, 1, 0, 0};
            pg8::EpiBf16<1> E{(bf16_t*)(ws + A_MID), 8192};
            pg8::gemm_phase(lds, g, E);
        } break;
        case 19: if constexpr (PHON(19) && PH == 19) {
            pg8::Gemm g{(const bf16_t*)(ws + A_MID), (const bf16_t*)(ws + W_W2T), 8192, 8192, 8192, 64, 8, 1, 0, 0};
            pg8::EpiBf16<0> E{X, 2048};
            pg8::gemm_phase(lds, g, E);
        } break;
        case 20: if constexpr (PHON(20) && PH == 20) { phase_norm<1>(p, NREAL, p.in[2] + 7 * DM, p.in[2] + 7 * DM, nullptr, 0, rep ? 0.f : 1.f); } break;
        default: break;
    }
}

__global__ __launch_bounds__(512, 2) void mega(Params p_arg, int ph_lo, int ph_hi) {
    extern __shared__ __attribute__((aligned(16))) unsigned char shm[];
    cg::grid_group grid = cg::this_grid();
    volatile LAS unsigned* xst = (volatile LAS unsigned*)((LAS unsigned char*)shm + 141312);
    if (threadIdx.x < 2) xst[threadIdx.x] = 0u;
    __syncthreads();
    const Params* pq0 = (const Params*)__builtin_amdgcn_kernarg_segment_ptr();
    const XcdBarrier xb = xcd_barrier_post((unsigned*)(pq0->ws + T_CTR), xst);
#define STEP(n) if (ph_lo <= (n) && (n) < ph_hi) { if ((n) > ph_lo) { if ((n) == 1 && ph_hi > 4096) grid.sync();   xcd_barrier(xb); } \
        const Params* pq = (const Params*)__builtin_amdgcn_kernarg_segment_ptr(); asm volatile("" : "+s"(pq)); \
        if constexpr ((REP_MASK >> (n)) & 1u) { int nrep = 2; asm volatile("" : "+s"(nrep)); \
            for (int rep = 0; rep < nrep; ++rep) { __syncthreads(); asm volatile("" : "+s"(pq)); phase_body<n>(*pq, (LAS unsigned char*)shm, shm, rep); } } \
        else phase_body<n>(*pq, (LAS unsigned char*)shm, shm); }
    STEP(0) STEP(1) STEP(2) STEP(3) STEP(4) STEP(5) STEP(6) STEP(7) STEP(8) STEP(9) STEP(10)
    STEP(11) STEP(12) STEP(13) STEP(14) STEP(15) STEP(16) STEP(17) STEP(18) STEP(19) STEP(20)
#undef STEP
}

#ifndef MK_ONE_LAUNCH
#define MK_ONE_LAUNCH 1
#endif
extern "C" void kernel_launch(void* const* d_in, const int* in_sizes, int n_in, void* d_out, int out_size, void* d_ws, size_t ws_size, hipStream_t stream) {
    static int ready = 0;
    if (!ready) {
        if (ws_size < WS_NEED) fprintf(stderr, "kernel_launch: workspace too small: %zu < %zu\n", ws_size, (size_t)WS_NEED);
        if (hipFuncSetAttribute((const void*)mega, hipFuncAttributeMaxDynamicSharedMemorySize, LDS_BYTES) != hipSuccess) fprintf(stderr, "kernel_launch: hipFuncSetAttribute failed\n");
        ready = 1;
    }
    Params p{};
    for (int i = 0; i < 30; ++i) p.in[i] = (const float*)d_in[i];
    p.out = (float*)d_out; p.ws = (unsigned char*)d_ws;
#if MK_ONE_LAUNCH
    (void)hipMemsetAsync((unsigned char*)d_ws + T_CTR, 0, XCD_BAR_WORDS * 4, stream);
    int lo = 0, hi = NPHASE;
    void* args[] = {&p, &lo, &hi};
    hipError_t e = hipLaunchCooperativeKernel((const void*)mega, dim3(256), dim3(512), args, LDS_BYTES, stream);
    if (e != hipSuccess) fprintf(stderr, "cooperative launch failed: %s\n", hipGetErrorString(e));
#else
    for (int ph = 0; ph < NPHASE; ++ph) hipLaunchKernelGGL(mega, dim3(256), dim3(512), LDS_BYTES, stream, p, ph, ph + 1);
#endif
}
```
